# Optimizing an MI355X kernel written in HIP

```python
import math
import jax, jax.numpy as jnp
from jax import lax
import numpy as np

D_MODEL = 1024
BATCH = 8
SEQ = 2048
DEPTH = 4

CHUNK = 64
D_A = D_MODEL
N_HEADS_A = 8
HEAD_DIM_A = D_A // N_HEADS_A
CONV_W = 4
D_B = D_MODEL
N_GROUPS_B = 8
GROUP_DIM_B = D_B // N_GROUPS_B
SGU_BLOCK = 128
EPS = 1e-6

OFF_Q = 0
OFF_K = OFF_Q + D_A
OFF_V = OFF_K + D_A
OFF_O = OFF_V + D_A
OFF_ZA = OFF_O + D_A
OFF_I = OFF_ZA + D_A
OFF_F = OFF_I + N_HEADS_A
OFF_U = OFF_F + N_HEADS_A
OFF_VB = OFF_U + D_B
OFF_ZB = OFF_VB + D_B
OFF_GA = OFF_ZB + D_B
OFF_GB = OFF_GA + D_MODEL
N_IN = OFF_GB + D_MODEL

kernel_name = "hybrid_mlstm_gmlp_gated_trunk"


def rmsnorm(x, w):
    xf = x.astype(jnp.float32)
    y = xf * lax.rsqrt(jnp.mean(xf * xf, axis=-1, keepdims=True) + EPS)
    return (y * w.astype(jnp.float32)).astype(x.dtype)


def causal_conv(x, w, bias):
    S = x.shape[1]
    xp = jnp.pad(x, ((0, 0), (CONV_W - 1, 0), (0, 0)))
    y = bias
    for j in range(CONV_W):
        y = y + w[j] * xp[:, j:j + S]
    return y


def mlstm_chunkwise(q, k, v, i_pre, f_pre):
    B, S, H, Dh = q.shape
    NC = S // CHUNK
    f32 = jnp.float32
    q = q.astype(f32).reshape(B, NC, CHUNK, H, Dh)
    k = (k.astype(f32) * (Dh ** -0.5)).reshape(B, NC, CHUNK, H, Dh)
    v = v.astype(f32).reshape(B, NC, CHUNK, H, Dh)
    log_i = i_pre.astype(f32).reshape(B, NC, CHUNK, H)
    log_f = jax.nn.log_sigmoid(f_pre.astype(f32)).reshape(B, NC, CHUNK, H)
    b = jnp.cumsum(log_f, axis=2)
    g = b[:, :, -1]
    a = g[:, :, None] - b + log_i
    m_loc = jnp.max(a, axis=2)
    wgt = jnp.exp(a - m_loc[:, :, None])
    kv = jnp.einsum('bnlh,bnlhd,bnlhe->bnhde', wgt, k, v)
    ksum = jnp.einsum('bnlh,bnlhd->bnhd', wgt, k)

    def step(carry, inp):
        C, n, m = carry
        kv_c, ks_c, ml_c, g_c = inp
        m_new = jnp.maximum(g_c + m, ml_c)
        decay = jnp.exp(g_c + m - m_new)
        scale = jnp.exp(ml_c - m_new)
        C_new = decay[..., None, None] * C + scale[..., None, None] * kv_c
        n_new = decay[..., None] * n + scale[..., None] * ks_c
        return (C_new, n_new, m_new), (C, n, m)

    init = (jnp.zeros((B, H, Dh, Dh), f32), jnp.zeros((B, H, Dh), f32), jnp.zeros((B, H), f32))
    xs = (jnp.moveaxis(kv, 1, 0), jnp.moveaxis(ksum, 1, 0),
          jnp.moveaxis(m_loc, 1, 0), jnp.moveaxis(g, 1, 0))
    _, (C_prev, n_prev, m_prev) = lax.scan(step, init, xs)
    C_prev = jnp.moveaxis(C_prev, 0, 1)
    n_prev = jnp.moveaxis(n_prev, 0, 1)
    m_prev = jnp.moveaxis(m_prev, 0, 1)

    inter_log = b + m_prev[:, :, None]
    D = b[:, :, :, None, :] - b[:, :, None, :, :] + log_i[:, :, None, :, :]
    causal = jnp.tril(jnp.ones((CHUNK, CHUNK), dtype=bool))[None, None, :, :, None]
    D = jnp.where(causal, D, -jnp.inf)
    m_t = jnp.maximum(inter_log, jnp.max(D, axis=3))
    P = jnp.exp(D - m_t[:, :, :, None]) * jnp.einsum('bnthd,bnshd->bntsh', q, k)
    inter_w = jnp.exp(inter_log - m_t)
    num = (inter_w[..., None] * jnp.einsum('bnthd,bnhde->bnthe', q, C_prev)
           + jnp.einsum('bntsh,bnshe->bnthe', P, v))
    den = inter_w * jnp.einsum('bnthd,bnhd->bnth', q, n_prev) + jnp.sum(P, axis=3)
    h = num / jnp.maximum(jnp.abs(den), jnp.exp(-m_t))[..., None]
    return h.reshape(B, S, H, Dh)


def spatial_gating(u, vb, norm_w, norm_b, w_s, b_s):
    B, S, _ = u.shape
    vf = vb.astype(jnp.float32)
    mu = jnp.mean(vf, axis=-1, keepdims=True)
    var = jnp.mean(jnp.square(vf - mu), axis=-1, keepdims=True)
    vn = (vf - mu) * lax.rsqrt(var + EPS) * norm_w.astype(jnp.float32) + norm_b.astype(jnp.float32)
    NB = S // SGU_BLOCK
    vn = vn.reshape(B, NB, SGU_BLOCK, N_GROUPS_B, GROUP_DIM_B)
    tri = jnp.tril(jnp.ones((SGU_BLOCK, SGU_BLOCK), dtype=jnp.float32))
    w_causal = w_s.astype(jnp.float32) * tri[None]
    mixed = jnp.einsum('gts,bnsgc->bntgc', w_causal, vn) + b_s.astype(jnp.float32).T[None, None, :, :, None]
    return u * mixed.reshape(B, S, D_B).astype(u.dtype)


def head_layernorm(h, w):
    mu = jnp.mean(h, axis=-1, keepdims=True)
    var = jnp.mean(jnp.square(h - mu), axis=-1, keepdims=True)
    hn = (h - mu) * lax.rsqrt(var + EPS)
    B, S, H, Dh = h.shape
    return hn.reshape(B, S, H * Dh) * w.astype(jnp.float32)


def setup_inputs(seed: int = 0) -> dict:
    key = jax.random.key(seed)
    ks = jax.random.split(key, 16)
    L = DEPTH
    nrm = jax.random.normal
    x = nrm(ks[0], (BATCH, SEQ, D_MODEL), jnp.float32)
    norm_pre = 1.0 + 0.01 * nrm(ks[1], (L, D_MODEL), jnp.float32)
    norm_post = 1.0 + 0.01 * nrm(ks[2], (L, D_MODEL), jnp.float32)
    w_in = nrm(ks[3], (L, D_MODEL, N_IN), jnp.float32) * (D_MODEL ** -0.5)
    b_in = 0.01 * nrm(ks[4], (L, N_IN), jnp.float32)
    b_in = b_in.at[:, OFF_F:OFF_F + N_HEADS_A].add(jnp.linspace(3.0, 6.0, N_HEADS_A, dtype=jnp.float32))
    conv_w = nrm(ks[5], (L, CONV_W, 2 * D_A), jnp.float32) * (CONV_W ** -0.5)
    conv_b = 0.01 * nrm(ks[6], (L, 2 * D_A), jnp.float32)
    mh_norm_w = 1.0 + 0.01 * nrm(ks[7], (L, D_A), jnp.float32)
    sgu_norm_w = 1.0 + 0.01 * nrm(ks[8], (L, D_B), jnp.float32)
    sgu_norm_b = 0.01 * nrm(ks[9], (L, D_B), jnp.float32)
    w_s = nrm(ks[10], (L, N_GROUPS_B, SGU_BLOCK, SGU_BLOCK), jnp.float32) * (SGU_BLOCK ** -0.5)
    b_s = 1.0 + 0.01 * nrm(ks[11], (L, N_GROUPS_B, SGU_BLOCK), jnp.float32)
    w_a = nrm(ks[12], (L, D_A, D_MODEL), jnp.float32) * (D_A ** -0.5)
    w_b = nrm(ks[13], (L, D_B, D_MODEL), jnp.float32) * (D_B ** -0.5)
    w_out = nrm(ks[14], (L, D_MODEL, D_MODEL), jnp.float32) * (D_MODEL ** -0.5)
    return {"x": x, "norm_pre": norm_pre, "norm_post": norm_post, "w_in": w_in, "b_in": b_in,
            "conv_w": conv_w, "conv_b": conv_b, "mh_norm_w": mh_norm_w,
            "sgu_norm_w": sgu_norm_w, "sgu_norm_b": sgu_norm_b, "w_s": w_s, "b_s": b_s,
            "w_a": w_a, "w_b": w_b, "w_out": w_out}


def reference(x, norm_pre, norm_post, w_in, b_in, conv_w, conv_b, mh_norm_w,
              sgu_norm_w, sgu_norm_b, w_s, b_s, w_a, w_b, w_out):
    B, S, _ = x.shape
    for l in range(DEPTH):
        h = rmsnorm(x, norm_pre[l])
        p = h @ w_in[l] + b_in[l]
        qk = jax.nn.silu(causal_conv(p[..., OFF_Q:OFF_V], conv_w[l], conv_b[l]))
        q = qk[..., :D_A].reshape(B, S, N_HEADS_A, HEAD_DIM_A)
        k = qk[..., D_A:].reshape(B, S, N_HEADS_A, HEAD_DIM_A)
        v = p[..., OFF_V:OFF_O].reshape(B, S, N_HEADS_A, HEAD_DIM_A)
        o_gate = jax.nn.sigmoid(p[..., OFF_O:OFF_ZA])
        z_a = p[..., OFF_ZA:OFF_I]
        i_pre = p[..., OFF_I:OFF_F]
        f_pre = p[..., OFF_F:OFF_U]
        h_a = mlstm_chunkwise(q, k, v, i_pre, f_pre)
        h_a = head_layernorm(h_a, mh_norm_w[l]).astype(x.dtype) * o_gate * jax.nn.silu(z_a)
        y_a = h_a @ w_a[l]
        uv = jax.nn.gelu(p[..., OFF_U:OFF_ZB])
        z_b = p[..., OFF_ZB:OFF_GA]
        h_b = spatial_gating(uv[..., :D_B], uv[..., D_B:], sgu_norm_w[l], sgu_norm_b[l], w_s[l], b_s[l])
        y_b = (h_b * jax.nn.silu(z_b)) @ w_b[l]
        g_a = jax.nn.sigmoid(p[..., OFF_GA:OFF_GB])
        g_b = jax.nn.sigmoid(p[..., OFF_GB:N_IN])
        out = (g_a * y_a + g_b * y_b) @ w_out[l]
        x = x + rmsnorm(out, norm_post[l])
    return x
```

```cpp
#include <hip/hip_runtime.h>
#include <cstdio>
#include <cstdint>

typedef unsigned short bf16;
constexpr int D = 1024, BATCH = 8, SEQ = 2048, M = BATCH * SEQ, DEPTH = 4, NH = 8, DH = 128, NG = 8, GD = 128, SGT = 128;
constexpr int OFF_Q = 0, OFF_K = 1024, OFF_V = 2048, OFF_O = 3072, OFF_ZA = 4096, OFF_I = 5120, OFF_F = 5128, OFF_U = 5136,
              OFF_VB = 6160, OFF_ZB = 7184, OFF_GA = 8208, OFF_GB = 9232, N_IN = 10256;
constexpr int NT1 = 41, NP1 = NT1 * 256;
constexpr float EPS = 1e-6f;

__host__ __device__ inline int src_col(int r) {
    const int t = r >> 8, j = r & 255;
    if (t < 8) return OFF_Q + r;
    if (t < 12) return OFF_V + (r - 2048);
    if (t < 20) return (j < 128 ? OFF_O : OFF_ZA) + 128 * (t - 12) + (j & 127);
    if (t < 28) return (j < 128 ? OFF_U : OFF_ZB) + 128 * (t - 20) + (j & 127);
    if (t < 32) return OFF_VB + (r - 7168);
    if (t < 36) return OFF_GA + (r - 8192);
    if (t < 40) return OFF_GB + (r - 9216);
    return j < 16 ? OFF_I + j : -1;
}

__device__ inline float bf2f(bf16 v) { return __uint_as_float((unsigned)v << 16); }
__device__ inline bf16 f2bf(float f) { unsigned u = __float_as_uint(f); return (bf16)((u + 0x7fffu + ((u >> 16) & 1u)) >> 16); }
__device__ inline float sigmoidf_(float x) { return 1.0f / (1.0f + __expf(-x)); }
__device__ inline float siluf_(float x) { return x * sigmoidf_(x); }
__device__ inline float geluf_(float x) { return x * sigmoidf_(1.5957691216057308f * (x + 0.044715f * x * x * x)); }
__device__ inline float wave_sum(float v) {
#pragma unroll
    for (int o = 1; o < 64; o <<= 1) v += __shfl_xor(v, o);
    return v;
}

constexpr size_t MiB = 1u << 20;
constexpr size_t WS_WIN = 1 * MiB;
constexpr size_t WS_WIN_SZ = (size_t)DEPTH * NP1 * D * 2;
constexpr size_t WS_WA = 84 * MiB, WS_WB = 92 * MiB, WS_WO = 100 * MiB;
constexpr size_t WS_B1 = 108 * MiB;
constexpr size_t WS_XN = 109 * MiB;
constexpr size_t WS_QK = 141 * MiB;
constexpr size_t WS_V  = 205 * MiB;
constexpr size_t WS_OZ = 237 * MiB;
constexpr size_t WS_UZ = 269 * MiB;
constexpr size_t WS_VB = 301 * MiB;
constexpr size_t WS_GA = 333 * MiB;
constexpr size_t WS_GB = 365 * MiB;
constexpr size_t WS_IF = 397 * MiB;
constexpr size_t WS_HA = 398 * MiB;
constexpr size_t WS_HB = 430 * MiB;
constexpr size_t WS_MG = 462 * MiB;
constexpr size_t WS_OUTRAW = 494 * MiB;
constexpr size_t WS_END = 558 * MiB;
static_assert(WS_WIN + WS_WIN_SZ <= WS_WA, "map");

__global__ void k_conv_win(const float* __restrict__ w_in, const float* __restrict__ b_in, bf16* __restrict__ WT, float* __restrict__ B1) {
    const int l = blockIdx.z;
    const int r = blockIdx.x * 64 + (threadIdx.x & 63);
    const int kbase = blockIdx.y * 64;
    const int sc = src_col(r);
    const float* W = w_in + (size_t)l * D * N_IN;
    bf16* wt = WT + (size_t)l * NP1 * D;
    for (int kk = threadIdx.x >> 6; kk < 64; kk += 4) {
        const int k = kbase + kk;
        const float v = sc >= 0 ? W[(size_t)k * N_IN + sc] : 0.f;
        wt[(size_t)r * D + k] = f2bf(v);
    }
    if (blockIdx.y == 0 && threadIdx.x < 64) B1[(size_t)l * NP1 + r] = sc >= 0 ? b_in[(size_t)l * N_IN + sc] : 0.f;
}
__global__ void k_conv_sq(const float* __restrict__ w, bf16* __restrict__ WT) {
    const int l = blockIdx.z;
    const int n = blockIdx.x * 64 + (threadIdx.x & 63);
    const int kbase = blockIdx.y * 64;
    for (int kk = threadIdx.x >> 6; kk < 64; kk += 4) {
        const int k = kbase + kk;
        WT[(size_t)l * D * D + (size_t)n * D + k] = f2bf(w[(size_t)l * D * D + (size_t)k * D + n]);
    }
}
__global__ void k_rms_rows(const float* __restrict__ x, const float* __restrict__ w, bf16* __restrict__ xn) {
    const int lane = threadIdx.x & 63, row = blockIdx.x * 4 + (threadIdx.x >> 6);
    const float* xr = x + (size_t)row * D;
    float v[16]; float s = 0.f;
#pragma unroll
    for (int j = 0; j < 16; ++j) { v[j] = xr[lane + 64 * j]; s += v[j] * v[j]; }
    const float rstd = rsqrtf(wave_sum(s) * (1.f / D) + EPS);
#pragma unroll
    for (int j = 0; j < 16; ++j) xn[(size_t)row * D + lane + 64 * j] = f2bf(v[j] * rstd * w[lane + 64 * j]);
}

__device__ inline void naive_tile(const bf16* __restrict__ A, int lda, const bf16* __restrict__ Bt, int ldb, int K, int row0, int col0,
                                  float (&acc)[4][16], float* sA, float* sB) {
    const int tid = threadIdx.x, tx = tid & 15, ty = tid >> 4;
#pragma unroll
    for (int i = 0; i < 4; ++i)
#pragma unroll
        for (int j = 0; j < 16; ++j) acc[i][j] = 0.f;
    for (int k0 = 0; k0 < K; k0 += 32) {
        for (int i = tid; i < 64 * 32; i += 256) { const int r = i >> 5, c = i & 31; sA[r * 33 + c] = bf2f(A[(size_t)(row0 + r) * lda + k0 + c]); }
        for (int i = tid; i < 256 * 32; i += 256) { const int r = i >> 5, c = i & 31; sB[r * 33 + c] = bf2f(Bt[(size_t)(col0 + r) * ldb + k0 + c]); }
        __syncthreads();
#pragma unroll 4
        for (int kk = 0; kk < 32; ++kk) {
            float a[4], b[16];
#pragma unroll
            for (int i = 0; i < 4; ++i) a[i] = sA[(ty * 4 + i) * 33 + kk];
#pragma unroll
            for (int j = 0; j < 16; ++j) b[j] = sB[(tx + 16 * j) * 33 + kk];
#pragma unroll
            for (int i = 0; i < 4; ++i)
#pragma unroll
                for (int j = 0; j < 16; ++j) acc[i][j] += a[i] * b[j];
        }
        __syncthreads();
    }
}

struct Bufs { bf16 *XN, *QK, *V, *OZ, *UZ, *VB, *GA, *GB, *HA, *HB, *MG; float *IF, *OUTRAW; };

__global__ void __launch_bounds__(256) k_p1(const bf16* __restrict__ XN, const bf16* __restrict__ WT, const float* __restrict__ B1, Bufs b) {
    __shared__ float sA[64 * 33], sB[256 * 33];
    const int row0 = blockIdx.x * 64, t = blockIdx.y, col0 = t * 256;
    float acc[4][16];
    naive_tile(XN, D, WT, D, D, row0, col0, acc, sA, sB);
    const int tx = threadIdx.x & 15, ty = threadIdx.x >> 4;
#pragma unroll
    for (int i = 0; i < 4; ++i) {
        const size_t row = row0 + ty * 4 + i;
#pragma unroll
        for (int jj = 0; jj < 16; ++jj) {
            const int j = tx + 16 * jj;
            const float v = acc[i][jj] + B1[col0 + j];
            if (t < 8) b.QK[row * 2048 + col0 + j] = f2bf(v);
            else if (t < 12) b.V[row * D + (col0 - 2048) + j] = f2bf(v);
            else if (t < 28) {
                if (jj < 8) {
                    const float v2 = acc[i][jj + 8] + B1[col0 + j + 128];
                    if (t < 20) b.OZ[row * D + 128 * (t - 12) + j] = f2bf(sigmoidf_(v) * siluf_(v2));
                    else b.UZ[row * D + 128 * (t - 20) + j] = f2bf(geluf_(v) * siluf_(v2));
                }
            }
            else if (t < 32) b.VB[row * D + 256 * (t - 28) + j] = f2bf(geluf_(v));
            else if (t < 36) b.GA[row * D + 256 * (t - 32) + j] = f2bf(sigmoidf_(v));
            else if (t < 40) b.GB[row * D + 256 * (t - 36) + j] = f2bf(sigmoidf_(v));
            else { if (j < 16) b.IF[row * 16 + j] = v; }
        }
    }
}

__global__ void __launch_bounds__(256) k_mlstm(Bufs b, const float* __restrict__ conv_w, const float* __restrict__ conv_b, const float* __restrict__ mhw) {
    __shared__ float sq[128], sk[128], sv[128], red[256], sred[8];
    const int bh = blockIdx.x, bb = bh >> 3, h = bh & 7, tid = threadIdx.x;
    const int dhalf = tid >> 7, e = tid & 127;
    const int ch = (tid < 128) ? (h * 128 + tid) : (1024 + h * 128 + (tid - 128));
    const float cw0 = conv_w[0 * 2048 + ch], cw1 = conv_w[1 * 2048 + ch], cw2 = conv_w[2 * 2048 + ch], cw3 = conv_w[3 * 2048 + ch], cb = conv_b[ch];
    float p1 = 0.f, p2 = 0.f, p3 = 0.f;
    float C[64];
#pragma unroll
    for (int i = 0; i < 64; ++i) C[i] = 0.f;
    float nst = 0.f;
    const float mw = mhw[h * 128 + e];
    for (int t = 0; t < SEQ; ++t) {
        const size_t row = (size_t)bb * SEQ + t;
        const float x0 = bf2f(b.QK[row * 2048 + ch]);
        float y = siluf_(cb + cw0 * p3 + cw1 * p2 + cw2 * p1 + cw3 * x0);
        p3 = p2; p2 = p1; p1 = x0;
        if (tid < 128) sq[tid] = y; else sk[tid - 128] = y * 0.08838834764831845f;
        if (tid < 128) sv[tid] = bf2f(b.V[row * D + h * 128 + tid]);
        const float ig = __expf(b.IF[row * 16 + h]), fg = sigmoidf_(b.IF[row * 16 + 8 + h]);
        __syncthreads();
        const float ve = sv[e];
        float pn = 0.f;
#pragma unroll
        for (int i = 0; i < 64; ++i) { const int d = dhalf * 64 + i; C[i] = fg * C[i] + (ig * sk[d]) * ve; pn += sq[d] * C[i]; }
        float dpart = 0.f;
        if (tid < 128) { nst = fg * nst + ig * sk[tid]; dpart = sq[tid] * nst; }
        red[tid] = pn;
        const float dsum = wave_sum(dpart);
        if ((tid & 63) == 0) sred[tid >> 6] = dsum;
        __syncthreads();
        const float den = sred[0] + sred[1];
        const float num = red[e] + red[128 + e];
        const float hv = num / fmaxf(fabsf(den), 1.0f);
        const float s1 = wave_sum(tid < 128 ? hv : 0.f);
        __syncthreads();
        if ((tid & 63) == 0) sred[tid >> 6] = s1;
        __syncthreads();
        const float mean = (sred[0] + sred[1]) * (1.f / 128.f);
        const float dv = hv - mean;
        const float s2 = wave_sum(tid < 128 ? dv * dv : 0.f);
        __syncthreads();
        if ((tid & 63) == 0) sred[tid >> 6] = s2;
        __syncthreads();
        const float var = (sred[0] + sred[1]) * (1.f / 128.f);
        if (tid < 128) {
            const float hn = dv * rsqrtf(var + EPS) * mw;
            b.HA[row * D + h * 128 + e] = f2bf(hn * bf2f(b.OZ[row * D + h * 128 + e]));
        }
        __syncthreads();
    }
}

__global__ void __launch_bounds__(256) k_sgu(Bufs b, const float* __restrict__ nw, const float* __restrict__ nb_, const float* __restrict__ ws, const float* __restrict__ bs) {
    __shared__ float vn[128 * 64];
    __shared__ float smu[128], srs[128];
    const int ch = blockIdx.x & 1, g = (blockIdx.x >> 1) & 7, nb = (blockIdx.x >> 4) & 15, bb = blockIdx.x >> 8;
    const int tid = threadIdx.x, lane = tid & 63, wv = tid >> 6;
    const size_t row0 = (size_t)bb * SEQ + nb * SGT;
    for (int s = wv; s < 128; s += 4) {
        const bf16* vr = b.VB + (row0 + s) * D;
        float x[16], sum = 0.f;
#pragma unroll
        for (int j = 0; j < 16; ++j) { x[j] = bf2f(vr[lane + 64 * j]); sum += x[j]; }
        const float mu = wave_sum(sum) * (1.f / D);
        float q = 0.f;
#pragma unroll
        for (int j = 0; j < 16; ++j) { const float d = x[j] - mu; q += d * d; }
        const float var = wave_sum(q) * (1.f / D);
        if (lane == 0) { smu[s] = mu; srs[s] = rsqrtf(var + EPS); }
    }
    __syncthreads();
    const int c = g * 128 + ch * 64 + lane;
    const float w_ = nw[c], b_ = nb_[c];
    for (int s = wv; s < 128; s += 4) vn[s * 64 + lane] = (bf2f(b.VB[(row0 + s) * D + c]) - smu[s]) * srs[s] * w_ + b_;
    __syncthreads();
    const float* W = ws + (size_t)g * SGT * SGT;
    for (int t = wv; t < 128; t += 4) {
        float acc = 0.f;
        for (int s = 0; s <= t; ++s) acc += W[t * SGT + s] * vn[s * 64 + lane];
        acc += bs[g * SGT + t];
        b.HB[(row0 + t) * D + c] = f2bf(bf2f(b.UZ[(row0 + t) * D + c]) * acc);
    }
}

__global__ void __launch_bounds__(256) k_p3(Bufs b, const bf16* __restrict__ WA, const bf16* __restrict__ WB) {
    __shared__ float sA[64 * 33], sB[256 * 33];
    const int row0 = blockIdx.x * 64, col0 = blockIdx.y * 256;
    const int tx = threadIdx.x & 15, ty = threadIdx.x >> 4;
    float acc[4][16], tmp[4][16];
    naive_tile(b.HA, D, WA, D, D, row0, col0, acc, sA, sB);
#pragma unroll
    for (int i = 0; i < 4; ++i)
#pragma unroll
        for (int jj = 0; jj < 16; ++jj) tmp[i][jj] = acc[i][jj] * bf2f(b.GA[(size_t)(row0 + ty * 4 + i) * D + col0 + tx + 16 * jj]);
    naive_tile(b.HB, D, WB, D, D, row0, col0, acc, sA, sB);
#pragma unroll
    for (int i = 0; i < 4; ++i)
#pragma unroll
        for (int jj = 0; jj < 16; ++jj) {
            const size_t o = (size_t)(row0 + ty * 4 + i) * D + col0 + tx + 16 * jj;
            b.MG[o] = f2bf(tmp[i][jj] + acc[i][jj] * bf2f(b.GB[o]));
        }
}
__global__ void __launch_bounds__(256) k_p4(Bufs b, const bf16* __restrict__ WO) {
    __shared__ float sA[64 * 33], sB[256 * 33];
    const int row0 = blockIdx.x * 64, col0 = blockIdx.y * 256;
    const int tx = threadIdx.x & 15, ty = threadIdx.x >> 4;
    float acc[4][16];
    naive_tile(b.MG, D, WO, D, D, row0, col0, acc, sA, sB);
#pragma unroll
    for (int i = 0; i < 4; ++i)
#pragma unroll
        for (int jj = 0; jj < 16; ++jj) b.OUTRAW[(size_t)(row0 + ty * 4 + i) * D + col0 + tx + 16 * jj] = acc[i][jj];
}
__global__ void k_p5(const float* __restrict__ xin, const float* __restrict__ outraw, const float* __restrict__ wpost, const float* __restrict__ wpre_next,
                     float* __restrict__ xout, bf16* __restrict__ xn) {
    const int lane = threadIdx.x & 63, row = blockIdx.x * 4 + (threadIdx.x >> 6);
    const size_t o = (size_t)row * D;
    float v[16], xv[16]; float s = 0.f;
#pragma unroll
    for (int j = 0; j < 16; ++j) { v[j] = outraw[o + lane + 64 * j]; s += v[j] * v[j]; }
    const float rstd = rsqrtf(wave_sum(s) * (1.f / D) + EPS);
    float s2 = 0.f;
#pragma unroll
    for (int j = 0; j < 16; ++j) { xv[j] = xin[o + lane + 64 * j] + v[j] * rstd * wpost[lane + 64 * j]; s2 += xv[j] * xv[j]; xout[o + lane + 64 * j] = xv[j]; }
    if (wpre_next) {
        const float r2 = rsqrtf(wave_sum(s2) * (1.f / D) + EPS);
#pragma unroll
        for (int j = 0; j < 16; ++j) xn[o + lane + 64 * j] = f2bf(xv[j] * r2 * wpre_next[lane + 64 * j]);
    }
}

extern "C" void kernel_launch(void* const* d_in, const int* in_sizes, int n_in, void* d_out, int out_size, void* d_ws, size_t ws_size, hipStream_t stream) {
    if (n_in != 15 || out_size != M * D || ws_size < WS_END) { fprintf(stderr, "kernel_launch: unexpected shapes n_in %d out %d ws %zu\n", n_in, out_size, ws_size); return; }
    const float* x = (const float*)d_in[0]; const float* norm_pre = (const float*)d_in[1]; const float* norm_post = (const float*)d_in[2];
    const float* w_in = (const float*)d_in[3]; const float* b_in = (const float*)d_in[4]; const float* conv_w = (const float*)d_in[5];
    const float* conv_b = (const float*)d_in[6]; const float* mhw = (const float*)d_in[7]; const float* sgw = (const float*)d_in[8];
    const float* sgb = (const float*)d_in[9]; const float* w_s = (const float*)d_in[10]; const float* b_s = (const float*)d_in[11];
    const float* w_a = (const float*)d_in[12]; const float* w_b = (const float*)d_in[13]; const float* w_out = (const float*)d_in[14];
    unsigned char* ws = (unsigned char*)d_ws;
    bf16* WIN = (bf16*)(ws + WS_WIN); bf16* WA = (bf16*)(ws + WS_WA); bf16* WB = (bf16*)(ws + WS_WB); bf16* WO = (bf16*)(ws + WS_WO);
    float* B1 = (float*)(ws + WS_B1);
    Bufs b; b.XN = (bf16*)(ws + WS_XN); b.QK = (bf16*)(ws + WS_QK); b.V = (bf16*)(ws + WS_V); b.OZ = (bf16*)(ws + WS_OZ); b.UZ = (bf16*)(ws + WS_UZ);
    b.VB = (bf16*)(ws + WS_VB); b.GA = (bf16*)(ws + WS_GA); b.GB = (bf16*)(ws + WS_GB); b.HA = (bf16*)(ws + WS_HA); b.HB = (bf16*)(ws + WS_HB);
    b.MG = (bf16*)(ws + WS_MG); b.IF = (float*)(ws + WS_IF); b.OUTRAW = (float*)(ws + WS_OUTRAW);
    float* out = (float*)d_out;

    k_conv_win<<<dim3(NP1 / 64, D / 64, DEPTH), 256, 0, stream>>>(w_in, b_in, WIN, B1);
    k_conv_sq<<<dim3(D / 64, D / 64, DEPTH), 256, 0, stream>>>(w_a, WA);
    k_conv_sq<<<dim3(D / 64, D / 64, DEPTH), 256, 0, stream>>>(w_b, WB);
    k_conv_sq<<<dim3(D / 64, D / 64, DEPTH), 256, 0, stream>>>(w_out, WO);
    k_rms_rows<<<M / 4, 256, 0, stream>>>(x, norm_pre, b.XN);
    for (int l = 0; l < DEPTH; ++l) {
        k_p1<<<dim3(M / 64, NT1), 256, 0, stream>>>(b.XN, WIN + (size_t)l * NP1 * D, B1 + (size_t)l * NP1, b);
        k_mlstm<<<BATCH * NH, 256, 0, stream>>>(b, conv_w + (size_t)l * 4 * 2048, conv_b + (size_t)l * 2048, mhw + (size_t)l * D);
        k_sgu<<<BATCH * 16 * NG * 2, 256, 0, stream>>>(b, sgw + (size_t)l * D, sgb + (size_t)l * D, w_s + (size_t)l * NG * SGT * SGT, b_s + (size_t)l * NG * SGT);
        k_p3<<<dim3(M / 64, D / 256), 256, 0, stream>>>(b, WA + (size_t)l * D * D, WB + (size_t)l * D * D);
        k_p4<<<dim3(M / 64, D / 256), 256, 0, stream>>>(b, WO + (size_t)l * D * D);
        k_p5<<<M / 4, 256, 0, stream>>>(l == 0 ? x : out, b.OUTRAW, norm_post + (size_t)l * D, l + 1 < DEPTH ? norm_pre + (size_t)(l + 1) * D : nullptr, out, b.XN);
    }
}
```

```cpp
#include <hip/hip_runtime.h>
#include <cstdio>
#include <cstdint>

#ifndef MK_ONE_LAUNCH
#define MK_ONE_LAUNCH 1
#endif

typedef unsigned short bf16;
constexpr int D = 1024, BATCH = 8, SEQ = 2048, M = BATCH * SEQ, DEPTH = 4, NH = 8, DH = 128, NG = 8, GD = 128, SGT = 128;
constexpr int OFF_Q = 0, OFF_K = 1024, OFF_V = 2048, OFF_O = 3072, OFF_ZA = 4096, OFF_I = 5120, OFF_F = 5128, OFF_U = 5136,
              OFF_VB = 6160, OFF_ZB = 7184, OFF_GA = 8208, OFF_GB = 9232, N_IN = 10256;
constexpr int NT1 = 41, NP1 = NT1 * 256;
constexpr float EPS = 1e-6f;

__host__ __device__ inline int src_col(int r) {
    const int t = r >> 8, j = r & 255;
    if (t < 8) return OFF_Q + r;
    if (t < 12) return OFF_V + (r - 2048);
    if (t < 20) return (j < 128 ? OFF_O : OFF_ZA) + 128 * (t - 12) + (j & 127);
    if (t < 28) return (j < 128 ? OFF_U : OFF_ZB) + 128 * (t - 20) + (j & 127);
    if (t < 32) return OFF_VB + (r - 7168);
    if (t < 36) return OFF_GA + (r - 8192);
    if (t < 40) return OFF_GB + (r - 9216);
    return j < 16 ? OFF_I + j : -1;
}

__device__ __forceinline__ float bf2f(bf16 v) { return __uint_as_float((unsigned)v << 16); }
__device__ __forceinline__ bf16 f2bf(float f) { unsigned u = __float_as_uint(f); return (bf16)((u + 0x7fffu + ((u >> 16) & 1u)) >> 16); }
__device__ __forceinline__ float fast_exp(float x) { return __builtin_amdgcn_exp2f(x * 1.4426950408889634f); }
__device__ __forceinline__ float sigmoidf_(float x) { return __builtin_amdgcn_rcpf(1.0f + fast_exp(-x)); }
__device__ __forceinline__ float siluf_(float x) { return x * sigmoidf_(x); }
__device__ __forceinline__ float geluf_(float x) { return x * sigmoidf_(1.5957691216057308f * (x + 0.044715f * x * x * x)); }
__device__ __forceinline__ float wave_sum(float v) {
#pragma unroll
    for (int o = 1; o < 64; o <<= 1) v += __shfl_xor(v, o);
    return v;
}

constexpr size_t MiB = 1u << 20;
constexpr size_t WS_CTL = 0, CTL_ZERO_BYTES = 1 * MiB;
constexpr size_t WS_WIN = 1 * MiB;
constexpr size_t WS_WIN_SZ = (size_t)DEPTH * NP1 * D * 2;
constexpr size_t WS_WAB = 84 * MiB;
constexpr size_t WS_WO = 100 * MiB;
constexpr size_t WS_B1 = 108 * MiB;
constexpr size_t WS_XN = 109 * MiB;
constexpr size_t WS_QK = 141 * MiB;
constexpr size_t WS_V  = 205 * MiB;
constexpr size_t WS_OZ = 237 * MiB;
constexpr size_t WS_UZ = 269 * MiB;
constexpr size_t WS_VB = 301 * MiB;
constexpr size_t WS_GA = 333 * MiB;
constexpr size_t WS_GB = 365 * MiB;
constexpr size_t WS_IF = 397 * MiB;
constexpr size_t WS_HA = 398 * MiB;
constexpr size_t WS_HB = 430 * MiB;
constexpr size_t WS_MG = 462 * MiB;
constexpr size_t WS_MGF = 494 * MiB;
constexpr size_t WS_OUTRAW = WS_MGF;
constexpr size_t WS_END = 558 * MiB;
static_assert(WS_WIN + WS_WIN_SZ <= WS_WAB && WS_HB == WS_HA + 32 * MiB, "map");
namespace pg8 {
#define PG8_LAS __attribute__((address_space(3)))
typedef unsigned short bf16_t;
typedef short bf16x8 __attribute__((ext_vector_type(8)));
typedef float f32x4 __attribute__((ext_vector_type(4)));
typedef unsigned u32x4 __attribute__((ext_vector_type(4)));
constexpr int BM = 256, BK = 64, HALF = 128, HTB = HALF * BK * 2  , STAGE_BYTES = 8 * HTB, NXCD = 8, WGM = 8;

__host__ __device__ __forceinline__ int lds_byte(int r, int c) { const int st = (r >> 4) * 2 + (c >> 5), rr = r & 15, cc = c & 31, ob = rr * 64 + cc * 2; return st * 1024 + (ob ^ (((ob >> 9) & 1) << 5)); }
__host__ __device__ __forceinline__ void stage_rc(int b, int& R, int& C) { const int st = b / 1024, sb = b % 1024, swz = sb ^ (((sb >> 9) & 1) << 5); R = (st >> 1) * 16 + swz / 64; C = (st & 1) * 32 + (swz % 64) / 2; }
__host__ __device__ __forceinline__ int perm32(int rho) { const int n = rho >> 4, i = rho & 15; return 8 * (i >> 2) + 4 * n + (i & 3); }

struct Unit { int pm, pn; };
struct Gemm { const bf16_t* A; const bf16_t* Bt; int M, N, K; };

struct StaticOrder {
    int nM, nN, nwg, G, c;
    __host__ __device__ void init(int M, int N, int G_, int c_) { nM = M / BM; nN = N / BM; nwg = nM * nN; G = G_; c = c_; }
    __host__ __device__ bool next(int i, Unit& u) const {
        const long L = (long)i * G + c; if (L >= nwg) return false;
        int wgid = (int)L; { const int q = nwg / NXCD, r = nwg % NXCD, xcd = wgid % NXCD, off = wgid / NXCD; wgid = (xcd < r ? xcd * (q + 1) : r * (q + 1) + (xcd - r) * q) + off; }
        const int nig = WGM * nN, gid = wgid / nig, fm = gid * WGM, gsz = (nM - fm) < WGM ? (nM - fm) : WGM;
        u.pm = fm + ((wgid % nig) % gsz); u.pn = (wgid % nig) / gsz; return true;
    }
    __device__ __forceinline__ void a_ready(const Unit&) const {}
    __device__ __forceinline__ void done(const Unit&) const {}
    __device__ __forceinline__ size_t a_off(const Unit&) const { return 0; }
};

typedef float f32x2_ __attribute__((ext_vector_type(2)));
typedef __bf16 bf16x2_ __attribute__((ext_vector_type(2)));
__device__ __forceinline__ unsigned cvt_pk_bf16(float lo, float hi) { const f32x2_ v = {lo, hi}; const bf16x2_ b = __builtin_convertvector(v, bf16x2_); return __builtin_bit_cast(unsigned, b); }
__device__ __forceinline__ u32x4 pack8(const f32x4& a, const f32x4& b) { u32x4 w; w.x = cvt_pk_bf16(a[0], a[1]); w.y = cvt_pk_bf16(a[2], a[3]); w.z = cvt_pk_bf16(b[0], b[1]); w.w = cvt_pk_bf16(b[2], b[3]); return w; }
__device__ __forceinline__ f32x4 unpack_lo(unsigned x, unsigned y) { return (f32x4){__uint_as_float(x << 16), __uint_as_float(x & 0xffff0000u), __uint_as_float(y << 16), __uint_as_float(y & 0xffff0000u)}; }
template <int ACT> __device__ __forceinline__ f32x4 act4(f32x4 v) {
    if (ACT == 0) return v;
    f32x4 r;
#pragma unroll
    for (int i = 0; i < 4; ++i) r[i] = ACT == 1 ? geluf_(v[i]) : (ACT == 2 ? sigmoidf_(v[i]) : siluf_(v[i]));
    return r;
}

struct EpiP1 {
    static constexpr bool PERM = true, AFTER_DRAIN = false;
    const float* bias;
    bf16_t *QK, *V, *OZ, *UZ, *VB, *GA, *GB; float* IF;
    template <int ACT> __device__ __forceinline__ void plain(const f32x4 (&acc)[2][2][4][2], const f32x4 (&bv)[2][2], bf16_t* base, int ldc, int row0) const {
#pragma unroll
        for (int ai = 0; ai < 2; ++ai)
#pragma unroll
            for (int m = 0; m < 4; ++m) { bf16_t* rowp = base + (size_t)(row0 + ai * HALF + m * 16) * ldc;
#pragma unroll
                for (int bj = 0; bj < 2; ++bj) { const f32x4 v0 = act4<ACT>(acc[ai][bj][m][0] + bv[bj][0]), v1 = act4<ACT>(acc[ai][bj][m][1] + bv[bj][1]);
                    *(u32x4*)(rowp + bj * HALF) = pack8(v0, v1); } }
    }
    template <int ACT> __device__ __forceinline__ void paired(const f32x4 (&acc)[2][2][4][2], const f32x4 (&bv)[2][2], bf16_t* base, int row0) const {
#pragma unroll
        for (int ai = 0; ai < 2; ++ai)
#pragma unroll
            for (int m = 0; m < 4; ++m) { bf16_t* rowp = base + (size_t)(row0 + ai * HALF + m * 16) * D;
                const f32x4 a0 = act4<ACT>(acc[ai][0][m][0] + bv[0][0]), a1 = act4<ACT>(acc[ai][0][m][1] + bv[0][1]);
                const f32x4 z0 = act4<3>(acc[ai][1][m][0] + bv[1][0]), z1 = act4<3>(acc[ai][1][m][1] + bv[1][1]);
                *(u32x4*)rowp = pack8(a0 * z0, a1 * z1); }
    }
    __device__ __forceinline__ void operator()(const f32x4 (&acc)[2][2][4][2], const Unit& u, int wr, int wc, int fr, int fq) const {
        asm volatile("" : "+v"(fr), "+v"(fq));
        const int t = u.pn, row0 = u.pm * BM + wr * 64 + fr, cb = wc * 32 + 8 * fq;
        f32x4 bv[2][2];
#pragma unroll
        for (int bj = 0; bj < 2; ++bj)
#pragma unroll
            for (int n = 0; n < 2; ++n) bv[bj][n] = *(const f32x4*)(bias + t * 256 + bj * HALF + cb + 4 * n);
        if (t < 8) plain<0>(acc, bv, QK + 256 * t + cb, 2048, row0);
        else if (t < 12) plain<0>(acc, bv, V + 256 * (t - 8) + cb, D, row0);
        else if (t < 20) paired<2>(acc, bv, OZ + 128 * (t - 12) + cb, row0);
        else if (t < 28) paired<1>(acc, bv, UZ + 128 * (t - 20) + cb, row0);
        else if (t < 32) plain<1>(acc, bv, VB + 256 * (t - 28) + cb, D, row0);
        else if (t < 36) plain<2>(acc, bv, GA + 256 * (t - 32) + cb, D, row0);
        else if (t < 40) plain<2>(acc, bv, GB + 256 * (t - 36) + cb, D, row0);
        else if (wc == 0 && fq < 2) {
#pragma unroll
            for (int ai = 0; ai < 2; ++ai)
#pragma unroll
                for (int m = 0; m < 4; ++m) { float* p = IF + (size_t)(row0 + ai * HALF + m * 16) * 16 + 8 * fq;
                    *(f32x4*)p = acc[ai][0][m][0] + bv[0][0]; *(f32x4*)(p + 4) = acc[ai][0][m][1] + bv[0][1]; }
        }
    }
};

struct EpiMerge {
    static constexpr bool PERM = true, AFTER_DRAIN = false;
    const bf16_t *GA, *GB; float* MGF; bf16_t* MG;
    __device__ __forceinline__ void operator()(const f32x4 (&acc)[2][2][4][2], const Unit& u, int wr, int wc, int fr, int fq) const {
        asm volatile("" : "+v"(fr), "+v"(fq));
        const bool second = u.pn >= 4; const int pn4 = u.pn & 3;
        const int row0 = u.pm * BM + wr * 64 + fr, col0 = pn4 * 256 + wc * 32 + 8 * fq;
        const bf16_t* G; if (second) G = GB; else G = GA;
        G += (size_t)row0 * D + col0; float* mp0 = MGF + (size_t)row0 * D + col0; bf16_t* mg0 = MG + (size_t)row0 * D + col0;
#pragma unroll
        for (int ai = 0; ai < 2; ++ai)
#pragma unroll
            for (int m = 0; m < 4; ++m) { const size_t o = (size_t)(ai * HALF + m * 16) * D;
#pragma unroll
                for (int bj = 0; bj < 2; ++bj) { const u32x4 g = *(const u32x4*)(G + o + bj * HALF);
                    const f32x4 g0 = unpack_lo(g.x, g.y), g1 = unpack_lo(g.z, g.w);
                    f32x4 v0 = acc[ai][bj][m][0] * g0, v1 = acc[ai][bj][m][1] * g1;
                    float* mp = mp0 + o + bj * HALF;
                    if (!second) { *(f32x4*)mp = v0; *(f32x4*)(mp + 4) = v1; }
                    else { v0 += *(const f32x4*)mp; v1 += *(const f32x4*)(mp + 4); *(u32x4*)(mg0 + o + bj * HALF) = pack8(v0, v1); } }
                asm volatile("" ::: "memory"); }
    }
};
struct PairOrder {
    int c; size_t hb_off;
    __device__ __forceinline__ bool next(int i, Unit& u) const {
        if (i >= 2) return false;
        u.pm = 8 * (c & 7) + ((c >> 3) & 7); u.pn = (c >> 6) + 4 * i; return true;
    }
    __device__ __forceinline__ void a_ready(const Unit&) const {}
    __device__ __forceinline__ void done(const Unit&) const {}
    __device__ __forceinline__ size_t a_off(const Unit& u) const { return u.pn >= 4 ? hb_off : 0; }
};
struct EpiF32 {
    static constexpr bool PERM = false, AFTER_DRAIN = false;
    float* C; int ldc;
    __device__ __forceinline__ void operator()(const f32x4 (&acc)[2][2][4][2], const Unit& u, int wr, int wc, int fr, int fq) const {
        asm volatile("" : "+v"(fr), "+v"(fq));
        const int row0 = u.pm * BM + wr * 64 + fr, col0 = u.pn * BM + wc * 32 + 4 * fq;
#pragma unroll
        for (int ai = 0; ai < 2; ++ai)
#pragma unroll
            for (int m = 0; m < 4; ++m) { float* rowp = C + (size_t)(row0 + ai * HALF + m * 16) * ldc + col0;
#pragma unroll
                for (int bj = 0; bj < 2; ++bj)
#pragma unroll
                    for (int n = 0; n < 2; ++n) *(f32x4*)(rowp + bj * HALF + n * 16) = acc[ai][bj][m][n]; }
    }
};

template <class Epi, class Sched, bool ALIGN_EPI = false, bool SP2 = false>
__device__ __forceinline__ void gemm_phase(PG8_LAS unsigned char* lds, const Gemm g, const Sched& S, const Epi& E) {
    int tid_ = threadIdx.x; asm volatile("" : "+v"(tid_));
    const int tid = tid_, wid = __builtin_amdgcn_readfirstlane(tid >> 6), lane = tid & 63, wr = wid >> 2, wc = wid & 3, fr = lane & 15, fq = lane >> 4;
    const int K = g.K, nt = K / BK;
    unsigned voffA[2], voffB[2];
#pragma unroll
    for (int i = 0; i < 2; ++i) { int R, C; stage_rc(tid * 16 + i * 8192, R, C); const int Rb = Epi::PERM ? ((R & ~31) + perm32(R & 31)) : R;
        voffA[i] = (unsigned)(R * K + C) * 2u; voffB[i] = (unsigned)(Rb * K + C) * 2u; }
    const size_t kstep = (size_t)(BK * 2);
    const size_t hstep = (size_t)HALF * K * 2;
    const size_t tstep = 2 * hstep;
    const unsigned ldsw = (unsigned)wid * 1024u;
    const int aoff = lds_byte(wr * 64 + fr, fq * 8), boff = lds_byte(wc * 32 + fr, fq * 8);
#define PG8_SA(b, h) (((b) * 2 + (h)) * HTB)
#define PG8_SB(b, h) ((4 + (b) * 2 + (h)) * HTB)
#define PG8_STAGE(bufoff, gbase, voff) do { _Pragma("unroll") for (int _i = 0; _i < 2; ++_i) \
        __builtin_amdgcn_global_load_lds((const unsigned*)((const char*)(gbase) + (voff)[_i]), (PG8_LAS unsigned*)(lds + (bufoff) + ldsw + _i * 8192), 16, 0, 0); } while (0)
#define PG8_LDA(dst, b, h) do { _Pragma("unroll") for (int m = 0; m < 4; ++m) _Pragma("unroll") for (int k = 0; k < 2; ++k) dst[m][k] = *(const PG8_LAS bf16x8*)(lds + PG8_SA(b, h) + aoff + m * 2048 + k * 1024); } while (0)
#define PG8_LDB(dst, b, h) do { _Pragma("unroll") for (int n = 0; n < 2; ++n) _Pragma("unroll") for (int k = 0; k < 2; ++k) dst[n][k] = *(const PG8_LAS bf16x8*)(lds + PG8_SB(b, h) + boff + n * 2048 + k * 1024); } while (0)
#define PG8_MMA(ai, bj, At, Bt) do { __builtin_amdgcn_s_setprio(1); _Pragma("unroll") for (int m = 0; m < 4; ++m) _Pragma("unroll") for (int n = 0; n < 2; ++n) _Pragma("unroll") for (int k = 0; k < 2; ++k) \
        acc[ai][bj][m][n] = __builtin_amdgcn_mfma_f32_16x16x32_bf16(Bt[n][k], At[m][k], acc[ai][bj][m][n], 0, 0, 0); __builtin_amdgcn_s_setprio(0); } while (0)
#define PG8_WAIT_V(n) asm volatile("s_waitcnt vmcnt(" #n ")" ::: "memory")
#define PG8_WAIT_L(n) asm volatile("s_waitcnt lgkmcnt(" #n ")" ::: "memory")
#define PG8_BAR __builtin_amdgcn_s_barrier()
#define PG8_SCHED __builtin_amdgcn_sched_barrier(0)
    Unit cur, nxt; int ui = 0;
    if (!S.next(0, cur)) return;
    f32x4 acc[2][2][4][2];
#pragma unroll
    for (int a = 0; a < 2; ++a)
#pragma unroll
        for (int b = 0; b < 2; ++b)
#pragma unroll
            for (int m = 0; m < 4; ++m)
#pragma unroll
                for (int n = 0; n < 2; ++n) acc[a][b][m][n] = (f32x4){0.f, 0.f, 0.f, 0.f};
    bf16x8 At[4][2], B0[2][2], B1[2][2];
    const char* cA = (const char*)g.A + S.a_off(cur) + (size_t)cur.pm * tstep; const char* cB = (const char*)g.Bt + (size_t)cur.pn * tstep;
    S.a_ready(cur);
    if constexpr (SP2) {
        PG8_STAGE(PG8_SB(0, 0), cB, voffB); PG8_STAGE(PG8_SB(0, 1), cB + hstep, voffB); PG8_STAGE(PG8_SA(0, 0), cA, voffA); PG8_STAGE(PG8_SA(0, 1), cA + hstep, voffA);
        if (wr == 1) PG8_BAR;
        PG8_WAIT_V(2); PG8_BAR;
        PG8_STAGE(PG8_SB(1, 0), cB + kstep, voffB); PG8_STAGE(PG8_SA(1, 0), cA + kstep, voffA); PG8_STAGE(PG8_SB(1, 1), cB + hstep + kstep, voffB);
        PG8_WAIT_V(6); PG8_BAR;
    } else {
        PG8_STAGE(PG8_SB(0, 0), cB, voffB); PG8_STAGE(PG8_SA(0, 0), cA, voffA); PG8_STAGE(PG8_SB(0, 1), cB + hstep, voffB); PG8_STAGE(PG8_SA(0, 1), cA + hstep, voffA);
        if (wr == 1) PG8_BAR;
        PG8_WAIT_V(4); PG8_BAR;
        PG8_STAGE(PG8_SB(1, 0), cB + kstep, voffB); PG8_STAGE(PG8_SA(1, 0), cA + kstep, voffA); PG8_STAGE(PG8_SB(1, 1), cB + hstep + kstep, voffB);
        PG8_WAIT_V(6); PG8_BAR;
    }
    for (;;) {
        const bool has_next = S.next(ui + 1, nxt);
        const char* nA = has_next ? (const char*)g.A + S.a_off(nxt) + (size_t)nxt.pm * tstep : cA; const char* nB = has_next ? (const char*)g.Bt + (size_t)nxt.pn * tstep : cB;
        for (int t = 0; t < nt; t += 2) {
            const bool last = (t == nt - 2);
            const char* a1 = cA + (size_t)(t + 1) * kstep;
            const char* a2 = last ? nA : cA + (size_t)(t + 2) * kstep; const char* b2 = last ? nB : cB + (size_t)(t + 2) * kstep;
            const char* a3 = a2 + kstep; const char* b3 = b2 + kstep;
            if (last && has_next) S.a_ready(nxt);
            if constexpr (SP2) {
            PG8_LDB(B0, 0, 0); PG8_LDB(B1, 0, 1); PG8_SCHED; PG8_LDA(At, 0, 0); PG8_STAGE(PG8_SA(1, 1), a1 + hstep, voffA);
            PG8_WAIT_V(8); PG8_WAIT_L(0); PG8_BAR; PG8_MMA(0, 0, At, B0); PG8_MMA(0, 1, At, B1); PG8_BAR; PG8_SCHED;
            PG8_LDA(At, 0, 1); PG8_STAGE(PG8_SB(0, 0), b2, voffB); PG8_STAGE(PG8_SB(0, 1), b2 + hstep, voffB); PG8_STAGE(PG8_SA(0, 0), a2, voffA);
            PG8_WAIT_V(8); PG8_WAIT_L(0); PG8_BAR; PG8_MMA(1, 0, At, B0); PG8_MMA(1, 1, At, B1); PG8_BAR; PG8_SCHED;
            PG8_LDB(B0, 1, 0); PG8_LDB(B1, 1, 1); PG8_SCHED; PG8_LDA(At, 1, 0); PG8_STAGE(PG8_SA(0, 1), a2 + hstep, voffA);
            PG8_WAIT_V(8); PG8_WAIT_L(0); PG8_BAR; PG8_MMA(0, 0, At, B0); PG8_MMA(0, 1, At, B1); PG8_BAR; PG8_SCHED;
            PG8_LDA(At, 1, 1); PG8_STAGE(PG8_SB(1, 0), b3, voffB); PG8_STAGE(PG8_SB(1, 1), b3 + hstep, voffB); PG8_STAGE(PG8_SA(1, 0), a3, voffA);
            PG8_WAIT_V(8); PG8_WAIT_L(0); PG8_BAR; PG8_MMA(1, 0, At, B0); PG8_MMA(1, 1, At, B1); PG8_BAR; PG8_SCHED;
            } else {
            PG8_LDB(B0, 0, 0); PG8_SCHED; PG8_LDA(At, 0, 0); PG8_STAGE(PG8_SA(1, 1), a1 + hstep, voffA);
            PG8_WAIT_L(8); PG8_BAR; PG8_WAIT_L(0); PG8_MMA(0, 0, At, B0); PG8_BAR; PG8_SCHED;
            PG8_LDB(B1, 0, 1); PG8_STAGE(PG8_SB(0, 0), b2, voffB);
            PG8_BAR; PG8_WAIT_L(0); PG8_MMA(0, 1, At, B1); PG8_BAR;
            PG8_LDA(At, 0, 1); PG8_STAGE(PG8_SA(0, 0), a2, voffA);
            PG8_BAR; PG8_WAIT_L(0); PG8_MMA(1, 0, At, B0); PG8_BAR; PG8_SCHED;
            PG8_STAGE(PG8_SB(0, 1), b2 + hstep, voffB);
            PG8_WAIT_V(6); PG8_BAR; PG8_MMA(1, 1, At, B1); PG8_BAR;
            PG8_LDB(B0, 1, 0); PG8_SCHED; PG8_LDA(At, 1, 0); PG8_STAGE(PG8_SA(0, 1), a2 + hstep, voffA);
            PG8_WAIT_L(8); PG8_BAR; PG8_WAIT_L(0); PG8_MMA(0, 0, At, B0); PG8_BAR; PG8_SCHED;
            PG8_LDB(B1, 1, 1); PG8_STAGE(PG8_SB(1, 0), b3, voffB);
            PG8_BAR; PG8_WAIT_L(0); PG8_MMA(0, 1, At, B1); PG8_BAR;
            PG8_LDA(At, 1, 1); PG8_STAGE(PG8_SA(1, 0), a3, voffA);
            PG8_BAR; PG8_WAIT_L(0); PG8_MMA(1, 0, At, B0); PG8_BAR; PG8_SCHED;
            PG8_STAGE(PG8_SB(1, 1), b3 + hstep, voffB);
            PG8_WAIT_V(6); PG8_BAR; PG8_MMA(1, 1, At, B1); PG8_BAR;
            }
        }
        if constexpr (ALIGN_EPI) { if (wr == 0) PG8_BAR; }
        if constexpr (!Epi::AFTER_DRAIN) { E(acc, cur, wr, wc, fr, fq); S.done(cur); }
        if (!has_next) break;
#pragma unroll
        for (int a = 0; a < 2; ++a)
#pragma unroll
            for (int b = 0; b < 2; ++b)
#pragma unroll
                for (int m = 0; m < 4; ++m)
#pragma unroll
                    for (int n = 0; n < 2; ++n) acc[a][b][m][n] = (f32x4){0.f, 0.f, 0.f, 0.f};
        cur = nxt; cA = nA; cB = nB; ++ui;
        if constexpr (ALIGN_EPI) { if (wr == 1) PG8_BAR; }
    }
    PG8_WAIT_V(0);
    if constexpr (!ALIGN_EPI) { if (wr == 0) PG8_BAR; }
    PG8_BAR;
    if constexpr (Epi::AFTER_DRAIN) { E.fused(acc, cur, wr, wc, fr, fq, lds, wid, lane); S.done(cur); }
#undef PG8_SA
#undef PG8_SB
#undef PG8_STAGE
#undef PG8_LDA
#undef PG8_LDB
#undef PG8_MMA
#undef PG8_WAIT_V
#undef PG8_WAIT_L
#undef PG8_BAR
#undef PG8_SCHED
}
}

constexpr int NWAVES = 8;
constexpr int RING_OFF = 0, RING_BYTES = 131072;
constexpr int LDSCTL_OFF = RING_BYTES, MISC_OFF = LDSCTL_OFF + 320;
constexpr int LDS_BYTES = 147456;
constexpr int CW_TMO = 0, CW_CODE = 1;
constexpr int CW_BAR = 4096;

#define GAS __attribute__((address_space(1)))
#define LAS __attribute__((address_space(3)))
typedef unsigned v4u __attribute__((ext_vector_type(4)));
typedef float f32x4 __attribute__((ext_vector_type(4)));
typedef GAS unsigned gu32;
typedef GAS unsigned long long gu64;
#define RLX_AGENT __ATOMIC_RELAXED, __HIP_MEMORY_SCOPE_AGENT
#define LDS_WAIT() asm volatile("s_waitcnt lgkmcnt(0)" ::: "memory")
#define VM_WAIT() asm volatile("s_waitcnt vmcnt(0)" ::: "memory")
__device__ __forceinline__ unsigned pk2(float lo, float hi) { return (unsigned)f2bf(lo) | ((unsigned)f2bf(hi) << 16); }

#define XB_TMO      128
#define XB_XCNT(j)  (256  + 64 * (j))
#define XB_XSUB(j)  (1280 + 64 * (j))
#define XB_XGEN(j)  (2304 + 64 * (j))
#define XB_TOP      3328
#define XB_TOPGEN   3392
#define XCD_BAR_WORDS 3456
#define XB_SPIN_CAP (1u << 18)

__device__ __forceinline__ unsigned xb_ld(unsigned* p)              { return __hip_atomic_load(p, __ATOMIC_RELAXED, __HIP_MEMORY_SCOPE_AGENT); }
__device__ __forceinline__ unsigned xb_add(unsigned* p, unsigned v) { return __hip_atomic_fetch_add(p, v, __ATOMIC_RELAXED, __HIP_MEMORY_SCOPE_AGENT); }
__device__ __forceinline__ unsigned xb_xcc_id() { return (unsigned)__builtin_amdgcn_s_getreg((3 << 11) | 20) & 0xFu; }
#define XB_SPIN(cond, bar) do { unsigned _sp = 0; while (cond) { __builtin_amdgcn_s_sleep(1); \
    if ((++_sp & 255u) == 0u) { if (xb_ld(&(bar)[XB_TMO])) break; if (_sp > XB_SPIN_CAP) { atomicAdd(&(bar)[XB_TMO], 1u); break; } } } } while (0)

struct XcdBarrier {
    unsigned* bar; unsigned x;
    volatile LAS unsigned* st;
};

__device__ __forceinline__ XcdBarrier xcd_barrier_post(unsigned* bar, volatile LAS unsigned* st) {
    XcdBarrier b; b.bar = bar; b.x = xb_xcc_id(); b.st = st;
    if (threadIdx.x == 0) (void)xb_add(&bar[XB_XCNT(b.x)], 1u);
    return b;
}
__device__ __forceinline__ void xcd_barrier_complete(unsigned* bar, unsigned x, unsigned& nloc, unsigned& nx) {
    const unsigned G = gridDim.x * gridDim.y * gridDim.z;
    unsigned sum, cnt, mine, sp = 0u;
    for (;;) {
        sum = 0u; cnt = 0u; mine = 0u;
#pragma unroll
        for (unsigned j = 0; j < 16; ++j) { const unsigned c = xb_ld(&bar[XB_XCNT(j)]); sum += c; cnt += (c > 0u) ? 1u : 0u; mine = (j == x) ? c : mine; }
        if (sum == G) break;
        __builtin_amdgcn_s_sleep(1);
        if ((++sp & 255u) == 0u) { if (xb_ld(&bar[XB_TMO])) break; if (sp > XB_SPIN_CAP) { atomicAdd(&bar[XB_TMO], 1u); break; } }
    }
    nloc = mine > 0u ? mine : 1u; nx = cnt > 0u ? cnt : 1u;
}

__device__ __forceinline__ void xcd_barrier(const XcdBarrier& b) {
    asm volatile("s_waitcnt vmcnt(0)" ::: "memory");
    __syncthreads();
    if (threadIdx.x == 0) {
        unsigned* bar = b.bar;
        __builtin_amdgcn_s_waitcnt(0);
        unsigned nloc = b.st[0], nx = b.st[1];
        if (nloc == 0u) { xcd_barrier_complete(bar, b.x, nloc, nx); b.st[0] = nloc; b.st[1] = nx; }
        const unsigned old = xb_add(&bar[XB_XSUB(b.x)], 1u);
        const unsigned gen = old / nloc;
        if (old + 1u == (gen + 1u) * nloc) {
            __builtin_amdgcn_fence(__ATOMIC_RELEASE, "agent");
            asm volatile("s_waitcnt vmcnt(0)" ::: "memory");
            const unsigned og = xb_add(&bar[XB_TOP], 1u);
            const unsigned tg = og / nx;
            if (og + 1u == (tg + 1u) * nx) xb_add(&bar[XB_TOPGEN], 1u);
            else XB_SPIN(xb_ld(&bar[XB_TOPGEN]) == tg, bar);
            __builtin_amdgcn_fence(__ATOMIC_ACQUIRE, "agent");
            xb_add(&bar[XB_XGEN(b.x)], 1u);
            asm volatile("s_waitcnt vmcnt(0)" ::: "memory");
        } else {
            XB_SPIN(xb_ld(&bar[XB_XGEN(b.x)]) == gen, bar);
            __builtin_amdgcn_fence(__ATOMIC_ACQUIRE, "agent");
            asm volatile("s_waitcnt vmcnt(0)" ::: "memory");
        }
    }
    __syncthreads();
}

struct Frame {
    LAS unsigned char* lds;
    volatile LAS unsigned* MISC;
    gu32* ctl;
    int tid, lane, wave, G;
    const float *x, *norm_pre, *norm_post, *w_in, *b_in, *conv_w, *conv_b, *mhw, *sgw, *sgb, *w_s, *b_s, *w_a, *w_b, *w_out;
    float* out;
    bf16 *WIN, *WAB, *WO; float* B1;
    bf16 *XN, *QK, *V, *OZ, *UZ, *VB, *GA, *GB, *HA, *HB, *MG; float *IF, *MGF, *OUTRAW;
};

__device__ __forceinline__ void p0_transpose_item(const float* W, int ldw, int src_c0, int nvalid, bf16* WTrow0, int K, int k0, LAS float* scr, int lane) {
    const int n_ = lane & 31;
#pragma unroll 8
    for (int i = 0; i < 32; ++i) { const int kk = 2 * i + (lane >> 5); scr[kk * 33 + n_] = (n_ < nvalid) ? W[(size_t)(k0 + kk) * ldw + src_c0 + n_] : 0.f; }
    LDS_WAIT(); asm volatile("" ::: "memory");
    const int c = lane & 7;
#pragma unroll
    for (int j = 0; j < 4; ++j) { const int n = (lane >> 3) + 8 * j; const LAS float* s = scr + (8 * c) * 33 + n;
        v4u o; o.x = pk2(s[0 * 33], s[1 * 33]); o.y = pk2(s[2 * 33], s[3 * 33]); o.z = pk2(s[4 * 33], s[5 * 33]); o.w = pk2(s[6 * 33], s[7 * 33]);
        *(GAS v4u*)(WTrow0 + (size_t)n * K + k0 + 8 * c) = o; }
    LDS_WAIT(); asm volatile("" ::: "memory");
}
__device__ __forceinline__ void rms_row_to_bf16(const float* xrow, const float* w, bf16* orow, int lane) {
    const GAS f32x4* xr = (const GAS f32x4*)xrow + lane; const GAS f32x4* wr = (const GAS f32x4*)w + lane;
    f32x4 v[4]; float s = 0.f;
#pragma unroll
    for (int j = 0; j < 4; ++j) { v[j] = xr[64 * j]; s += (v[j].x * v[j].x + v[j].y * v[j].y) + (v[j].z * v[j].z + v[j].w * v[j].w); }
    const float rstd = rsqrtf(wave_sum(s) * (1.f / D) + EPS);
    GAS unsigned long long* o8 = (GAS unsigned long long*)orow + lane;
#pragma unroll
    for (int j = 0; j < 4; ++j) { const f32x4 ww = wr[64 * j];
        o8[64 * j] = (unsigned long long)pk2(v[j].x * rstd * ww.x, v[j].y * rstd * ww.y) | ((unsigned long long)pk2(v[j].z * rstd * ww.z, v[j].w * rstd * ww.w) << 32); }
}
__device__ __forceinline__ void p0_prologue(Frame& F) {
    LAS float* scr = (LAS float*)(F.lds + RING_OFF + F.wave * 16384);
    const int gw = blockIdx.x * NWAVES + F.wave, NGW = F.G * NWAVES;
    constexpr int I_IN = (D / 64) * (NP1 / 32), I_SQ = (D / 64) * (D / 32), I_L = I_IN + 3 * I_SQ, NITEMS = DEPTH * I_L;
    for (int it = gw; it < NITEMS; it += NGW) {
        const int l = it / I_L; int r = it - l * I_L;
        if (r < I_IN) { const int kb = r / (NP1 / 32), nb = r % (NP1 / 32), r0 = nb * 32; const int sc = src_col(r0);
            const int nvalid = sc < 0 ? 0 : ((r0 >> 8) == 40 ? 16 : 32);
            p0_transpose_item(F.w_in + (size_t)l * D * N_IN, N_IN, sc < 0 ? 0 : sc, nvalid, F.WIN + ((size_t)l * NP1 + r0) * D, D, kb * 64, scr, F.lane); continue; }
        r -= I_IN; const int which = r / I_SQ; r -= which * I_SQ;
        const int kb = r / (D / 32), nb = r % (D / 32);
        const float* W; bf16* WT;
        if (which == 0) { W = F.w_a; WT = F.WAB + (size_t)l * 2048 * D; } else if (which == 1) { W = F.w_b; WT = F.WAB + ((size_t)l * 2048 + 1024) * D; } else { W = F.w_out; WT = F.WO + (size_t)l * D * D; }
        W += (size_t)l * D * D;
        p0_transpose_item(W, D, nb * 32, 32, WT + (size_t)nb * 32 * D, D, kb * 64, scr, F.lane);
    }
    for (int i = blockIdx.x * 512 + F.tid; i < DEPTH * NP1; i += F.G * 512) { const int l = i / NP1, r = i - l * NP1; const int sc = src_col(r); F.B1[i] = sc >= 0 ? F.b_in[(size_t)l * N_IN + sc] : 0.f; }
    for (int m = gw; m < M; m += NGW) rms_row_to_bf16(F.x + (size_t)m * D, F.norm_pre, F.XN + (size_t)m * D, F.lane);
}

__device__ __forceinline__ void mlstm_simple(Frame& F, int bh, int l) {
    LAS float* sq = (LAS float*)F.lds; LAS float* sk = sq + 128; LAS float* sv = sk + 128; LAS float* red = sv + 128; LAS float* sred = red + 512;
    const int bb = bh >> 3, h = bh & 7, tid = F.tid, dq = tid >> 7, e = tid & 127;
    const float* conv_w = F.conv_w + (size_t)l * 4 * 2048; const float* conv_b = F.conv_b + (size_t)l * 2048;
    const int ch = (tid < 128) ? (h * 128 + tid) : (1024 + h * 128 + ((tid - 128) & 127));
    const float cw0 = conv_w[0 * 2048 + ch], cw1 = conv_w[1 * 2048 + ch], cw2 = conv_w[2 * 2048 + ch], cw3 = conv_w[3 * 2048 + ch], cb = conv_b[ch];
    float p1 = 0.f, p2 = 0.f, p3 = 0.f;
    float C[32];
#pragma unroll
    for (int i = 0; i < 32; ++i) C[i] = 0.f;
    float nst = 0.f;
    const float mw = F.mhw[(size_t)l * D + h * 128 + e];
    for (int t = 0; t < SEQ; ++t) {
        const size_t row = (size_t)bb * SEQ + t;
        if (tid < 256) {
            const float x0 = bf2f(F.QK[row * 2048 + ch]);
            const float y = siluf_(cb + cw0 * p3 + cw1 * p2 + cw2 * p1 + cw3 * x0);
            p3 = p2; p2 = p1; p1 = x0;
            if (tid < 128) sq[tid] = y; else sk[tid - 128] = y * 0.08838834764831845f;
        } else if (tid < 384) sv[tid - 256] = bf2f(F.V[row * D + h * 128 + (tid - 256)]);
        const float ig = __expf(F.IF[row * 16 + h]), fg = sigmoidf_(F.IF[row * 16 + 8 + h]);
        __syncthreads();
        const float ve = sv[e];
        float pn = 0.f;
#pragma unroll
        for (int i = 0; i < 32; ++i) { const int d = dq * 32 + i; C[i] = fg * C[i] + (ig * sk[d]) * ve; pn += sq[d] * C[i]; }
        float dpart = 0.f;
        if (tid < 128) { nst = fg * nst + ig * sk[tid]; dpart = sq[tid] * nst; }
        red[tid] = pn;
        const float dsum = wave_sum(dpart);
        if (F.lane == 0) sred[F.wave] = dsum;
        __syncthreads();
        const float den = sred[0] + sred[1];
        const float num = (red[e] + red[128 + e]) + (red[256 + e] + red[384 + e]);
        const float hv = num / fmaxf(fabsf(den), 1.0f);
        const float s1 = wave_sum(tid < 128 ? hv : 0.f);
        __syncthreads();
        if (F.lane == 0) sred[F.wave] = s1;
        __syncthreads();
        const float mean = (sred[0] + sred[1]) * (1.f / 128.f);
        const float dv = hv - mean;
        const float s2 = wave_sum(tid < 128 ? dv * dv : 0.f);
        __syncthreads();
        if (F.lane == 0) sred[F.wave] = s2;
        __syncthreads();
        const float var = (sred[0] + sred[1]) * (1.f / 128.f);
        if (tid < 128) {
            const float hn = dv * rsqrtf(var + EPS) * mw;
            F.HA[row * D + h * 128 + e] = f2bf(hn * bf2f(F.OZ[row * D + h * 128 + e]));
        }
        __syncthreads();
    }
}
__device__ __forceinline__ void sgu_simple(Frame& F, int u, int l) {
    LAS float* vn = (LAS float*)F.lds; LAS float* smu = vn + 128 * 64; LAS float* srs = smu + 128;
    const int ch = u & 1, g = (u >> 1) & 7, nb = (u >> 4) & 15, bb = u >> 8;
    const int lane = F.lane, wv = F.wave;
    const size_t row0 = (size_t)bb * SEQ + nb * SGT;
    for (int s = wv; s < 128; s += NWAVES) {
        const bf16* vr = F.VB + (row0 + s) * D;
        float x[16], sum = 0.f;
#pragma unroll
        for (int j = 0; j < 16; ++j) { x[j] = bf2f(vr[lane + 64 * j]); sum += x[j]; }
        const float mu = wave_sum(sum) * (1.f / D);
        float q = 0.f;
#pragma unroll
        for (int j = 0; j < 16; ++j) { const float d = x[j] - mu; q += d * d; }
        const float var = wave_sum(q) * (1.f / D);
        if (lane == 0) { smu[s] = mu; srs[s] = rsqrtf(var + EPS); }
    }
    __syncthreads();
    const int c = g * 128 + ch * 64 + lane;
    const float w_ = F.sgw[(size_t)l * D + c], b_ = F.sgb[(size_t)l * D + c];
    for (int s = wv; s < 128; s += NWAVES) vn[s * 64 + lane] = (bf2f(F.VB[(row0 + s) * D + c]) - smu[s]) * srs[s] * w_ + b_;
    __syncthreads();
    const float* W = F.w_s + ((size_t)l * NG + g) * SGT * SGT;
    const float* bs = F.b_s + ((size_t)l * NG + g) * SGT;
    for (int t = wv; t < 128; t += NWAVES) {
        float acc = 0.f;
        for (int s = 0; s <= t; ++s) acc += W[t * SGT + s] * vn[s * 64 + lane];
        acc += bs[t];
        F.HB[(row0 + t) * D + c] = f2bf(bf2f(F.UZ[(row0 + t) * D + c]) * acc);
    }
    __syncthreads();
}
__device__ __forceinline__ void p5_rows(Frame& F, int l) {
    const int gw = blockIdx.x * NWAVES + F.wave, NGW = F.G * NWAVES, lane = F.lane;
    const float* xin; if (l == 0) xin = F.x; else xin = F.out;
    const GAS f32x4* wpost = (const GAS f32x4*)(F.norm_post + (size_t)l * D) + lane;
    const GAS f32x4* wpre = (const GAS f32x4*)(F.norm_pre + (size_t)(l + 1 < DEPTH ? l + 1 : l) * D) + lane;
    for (int m = gw; m < M; m += NGW) {
        const GAS f32x4* orow = (const GAS f32x4*)(F.OUTRAW + (size_t)m * D) + lane; const GAS f32x4* xr = (const GAS f32x4*)(xin + (size_t)m * D) + lane;
        GAS f32x4* xo = (GAS f32x4*)(F.out + (size_t)m * D) + lane;
        f32x4 v[4], xv[4]; float s = 0.f;
#pragma unroll
        for (int j = 0; j < 4; ++j) { v[j] = orow[64 * j]; xv[j] = xr[64 * j]; s += (v[j].x * v[j].x + v[j].y * v[j].y) + (v[j].z * v[j].z + v[j].w * v[j].w); }
        const float rstd = rsqrtf(wave_sum(s) * (1.f / D) + EPS); float s2 = 0.f;
#pragma unroll
        for (int j = 0; j < 4; ++j) { xv[j] = xv[j] + v[j] * rstd * wpost[64 * j]; xo[64 * j] = xv[j]; s2 += (xv[j].x * xv[j].x + xv[j].y * xv[j].y) + (xv[j].z * xv[j].z + xv[j].w * xv[j].w); }
        if (l + 1 < DEPTH) {
            const float r2 = rsqrtf(wave_sum(s2) * (1.f / D) + EPS);
            GAS unsigned long long* o8 = (GAS unsigned long long*)(F.XN + (size_t)m * D) + lane;
#pragma unroll
            for (int j = 0; j < 4; ++j) { const f32x4 ww = wpre[64 * j];
                o8[64 * j] = (unsigned long long)pk2(xv[j].x * r2 * ww.x, xv[j].y * r2 * ww.y) | ((unsigned long long)pk2(xv[j].z * r2 * ww.z, xv[j].w * r2 * ww.w) << 32); }
        }
    }
}


#ifndef PG8_SP2
#define PG8_SP2 true
#endif
#ifndef PG8_ALIGN
#define PG8_ALIGN true
#endif
#ifndef NAIVE_MASK
#define NAIVE_MASK 0
#endif
__device__ __forceinline__ void naive_tile(Frame& F, const bf16* A, const bf16* Bt, int row0, int col0, float (&acc)[2][16]) {
    LAS float* sA = (LAS float*)F.lds; LAS float* sB = sA + 64 * 33;
    const int tid = F.tid, tx = tid & 15, ty = tid >> 4;
#pragma unroll
    for (int i = 0; i < 2; ++i)
#pragma unroll
        for (int j = 0; j < 16; ++j) acc[i][j] = 0.f;
    for (int k0 = 0; k0 < D; k0 += 32) {
        for (int i = tid; i < 64 * 32; i += 512) { const int r = i >> 5, c = i & 31; sA[r * 33 + c] = bf2f(A[(size_t)(row0 + r) * D + k0 + c]); }
        for (int i = tid; i < 256 * 32; i += 512) { const int r = i >> 5, c = i & 31; sB[r * 33 + c] = bf2f(Bt[(size_t)(col0 + r) * D + k0 + c]); }
        __syncthreads();
#pragma unroll 4
        for (int kk = 0; kk < 32; ++kk) {
            float a[2], b[16];
#pragma unroll
            for (int i = 0; i < 2; ++i) a[i] = sA[(ty * 2 + i) * 33 + kk];
#pragma unroll
            for (int j = 0; j < 16; ++j) b[j] = sB[(tx + 16 * j) * 33 + kk];
#pragma unroll
            for (int i = 0; i < 2; ++i)
#pragma unroll
                for (int j = 0; j < 16; ++j) acc[i][j] += a[i] * b[j];
        }
        __syncthreads();
    }
}
__device__ __forceinline__ void naive_p1(Frame& F, int l) {
    const bf16* WT = F.WIN + (size_t)l * NP1 * D; const float* B1 = F.B1 + (size_t)l * NP1;
    const int tx = F.tid & 15, ty = F.tid >> 4;
    for (int it = blockIdx.x; it < (M / 64) * NT1; it += F.G) {
        const int t = it % NT1, row0 = (it / NT1) * 64, col0 = t * 256;
        float acc[2][16];
        naive_tile(F, F.XN, WT, row0, col0, acc);
#pragma unroll
        for (int i = 0; i < 2; ++i) { const size_t row = row0 + ty * 2 + i;
#pragma unroll
            for (int jj = 0; jj < 16; ++jj) { const int j = tx + 16 * jj; const float v = acc[i][jj] + B1[col0 + j];
                if (t < 8) F.QK[row * 2048 + col0 + j] = f2bf(v);
                else if (t < 12) F.V[row * D + (col0 - 2048) + j] = f2bf(v);
                else if (t < 28) { if (jj < 8) { const float v2 = acc[i][jj + 8] + B1[col0 + j + 128];
                        if (t < 20) F.OZ[row * D + 128 * (t - 12) + j] = f2bf(sigmoidf_(v) * siluf_(v2)); else F.UZ[row * D + 128 * (t - 20) + j] = f2bf(geluf_(v) * siluf_(v2)); } }
                else if (t < 32) F.VB[row * D + 256 * (t - 28) + j] = f2bf(geluf_(v));
                else if (t < 36) F.GA[row * D + 256 * (t - 32) + j] = f2bf(sigmoidf_(v));
                else if (t < 40) F.GB[row * D + 256 * (t - 36) + j] = f2bf(sigmoidf_(v));
                else { if (j < 16) F.IF[row * 16 + j] = v; } } }
    }
}
__device__ __forceinline__ void naive_p3(Frame& F, int l) {
    const bf16* WA = F.WAB + (size_t)l * 2048 * D; const bf16* WB = WA + (size_t)1024 * D;
    const int tx = F.tid & 15, ty = F.tid >> 4;
    for (int it = blockIdx.x; it < (M / 64) * 4; it += F.G) {
        const int row0 = (it >> 2) * 64, col0 = (it & 3) * 256;
        float acc[2][16], tmp[2][16];
        naive_tile(F, F.HA, WA, row0, col0, acc);
#pragma unroll
        for (int i = 0; i < 2; ++i)
#pragma unroll
            for (int jj = 0; jj < 16; ++jj) tmp[i][jj] = acc[i][jj] * bf2f(F.GA[(size_t)(row0 + ty * 2 + i) * D + col0 + tx + 16 * jj]);
        naive_tile(F, F.HB, WB, row0, col0, acc);
#pragma unroll
        for (int i = 0; i < 2; ++i)
#pragma unroll
            for (int jj = 0; jj < 16; ++jj) { const size_t o = (size_t)(row0 + ty * 2 + i) * D + col0 + tx + 16 * jj; F.MG[o] = f2bf(tmp[i][jj] + acc[i][jj] * bf2f(F.GB[o])); }
    }
}
__device__ __forceinline__ void naive_p4(Frame& F, int l) {
    const bf16* WO = F.WO + (size_t)l * D * D;
    const int tx = F.tid & 15, ty = F.tid >> 4;
    for (int it = blockIdx.x; it < (M / 64) * 4; it += F.G) {
        const int row0 = (it >> 2) * 64, col0 = (it & 3) * 256;
        float acc[2][16];
        naive_tile(F, F.MG, WO, row0, col0, acc);
#pragma unroll
        for (int i = 0; i < 2; ++i)
#pragma unroll
            for (int jj = 0; jj < 16; ++jj) F.OUTRAW[(size_t)(row0 + ty * 2 + i) * D + col0 + tx + 16 * jj] = acc[i][jj];
    }
}

struct Args { const float* in[15]; float* out; unsigned char* ws; int ph_lo, ph_hi, li, pad; };
constexpr int NPHASES = 1 + 5 * DEPTH;
#ifndef PHSEL
#define PHSEL 63
#endif
__global__ void __launch_bounds__(NWAVES * 64, 2) mk_fwd(Args args) {
    extern __shared__ __attribute__((aligned(16))) unsigned char lds[];
    Frame F;
    F.lds = (LAS unsigned char*)lds;
    F.MISC = (volatile LAS unsigned*)(F.lds + MISC_OFF);
    F.tid = threadIdx.x; F.lane = F.tid & 63; F.wave = __builtin_amdgcn_readfirstlane(F.tid >> 6); F.G = gridDim.x;
    unsigned char* ws = args.ws;
    F.ctl = (gu32*)(ws + WS_CTL);
    F.x = args.in[0]; F.norm_pre = args.in[1]; F.norm_post = args.in[2]; F.w_in = args.in[3]; F.b_in = args.in[4]; F.conv_w = args.in[5]; F.conv_b = args.in[6];
    F.mhw = args.in[7]; F.sgw = args.in[8]; F.sgb = args.in[9]; F.w_s = args.in[10]; F.b_s = args.in[11]; F.w_a = args.in[12]; F.w_b = args.in[13]; F.w_out = args.in[14];
    F.out = args.out;
    F.WIN = (bf16*)(ws + WS_WIN); F.WAB = (bf16*)(ws + WS_WAB); F.WO = (bf16*)(ws + WS_WO); F.B1 = (float*)(ws + WS_B1);
    F.XN = (bf16*)(ws + WS_XN); F.QK = (bf16*)(ws + WS_QK); F.V = (bf16*)(ws + WS_V); F.OZ = (bf16*)(ws + WS_OZ); F.UZ = (bf16*)(ws + WS_UZ); F.VB = (bf16*)(ws + WS_VB);
    F.GA = (bf16*)(ws + WS_GA); F.GB = (bf16*)(ws + WS_GB); F.HA = (bf16*)(ws + WS_HA); F.HB = (bf16*)(ws + WS_HB); F.MG = (bf16*)(ws + WS_MG);
    F.IF = (float*)(ws + WS_IF); F.MGF = (float*)(ws + WS_MGF); F.OUTRAW = (float*)(ws + WS_OUTRAW);
    for (int u = F.tid; u < (LDS_BYTES - LDSCTL_OFF) / 4; u += NWAVES * 64) ((LAS unsigned*)(F.lds + LDSCTL_OFF))[u] = 0u;
    __syncthreads();
    const int lo = args.ph_lo, hi = args.ph_hi;
    XcdBarrier bar; bar.bar = (unsigned*)(F.ctl + CW_BAR); bar.x = 0; bar.st = nullptr;
    if (hi - lo > 1) bar = xcd_barrier_post((unsigned*)(F.ctl + CW_BAR), F.MISC + 8);

    for (int ph = lo; ph < hi; ++ph) {
        { int t_ = threadIdx.x; asm volatile("" : "+v"(t_)); F.tid = t_; F.lane = t_ & 63; }
        if (ph == 0) { if (PHSEL & 1) p0_prologue(F); }
        else {
            const int l = (ph - 1) / 5, sub = (ph - 1) % 5;
            if (sub == 0 && (NAIVE_MASK & 1)) naive_p1(F, l);
            else if (sub == 2 && (NAIVE_MASK & 2)) naive_p3(F, l);
            else if (sub == 3 && (NAIVE_MASK & 4)) naive_p4(F, l);
            else if (sub == 0 && (PHSEL & 2)) {
                pg8::Gemm g{F.XN, F.WIN + (size_t)l * NP1 * D, M, NP1, D}; pg8::StaticOrder S; S.init(M, NP1, F.G, (int)blockIdx.x);
                pg8::EpiP1 E{F.B1 + (size_t)l * NP1, F.QK, F.V, F.OZ, F.UZ, F.VB, F.GA, F.GB, F.IF};
                pg8::gemm_phase<pg8::EpiP1, pg8::StaticOrder, PG8_ALIGN, PG8_SP2>(F.lds + RING_OFF, g, S, E);
            } else if (sub == 1 && (PHSEL & 4)) {
                if (blockIdx.x < 64) mlstm_simple(F, blockIdx.x, l);
                else for (int u = blockIdx.x - 64; u < BATCH * 16 * NG * 2; u += F.G - 64) sgu_simple(F, u, l);
            } else if (sub == 2 && (PHSEL & 8)) {
                if (F.G == 256) {
                    pg8::Gemm g{F.HA, F.WAB + (size_t)l * 2048 * D, M, 2048, D}; pg8::PairOrder S{(int)blockIdx.x, (size_t)(WS_HB - WS_HA)};
                    pg8::EpiMerge E{F.GA, F.GB, F.MGF, F.MG};
                    pg8::gemm_phase<pg8::EpiMerge, pg8::PairOrder, PG8_ALIGN, PG8_SP2>(F.lds + RING_OFF, g, S, E);
                }
            } else if (sub == 3 && (PHSEL & 16)) {
                pg8::Gemm g{F.MG, F.WO + (size_t)l * D * D, M, D, D}; pg8::StaticOrder S; S.init(M, D, F.G, (int)blockIdx.x);
                pg8::EpiF32 E{F.OUTRAW, D};
                pg8::gemm_phase<pg8::EpiF32, pg8::StaticOrder, PG8_ALIGN, PG8_SP2>(F.lds + RING_OFF, g, S, E);
            } else if (sub == 4 && (PHSEL & 32)) p5_rows(F, l);
        }
        if (ph + 1 < hi) xcd_barrier(bar);
    }
}

extern "C" void kernel_launch(void* const* d_in, const int* in_sizes, int n_in, void* d_out, int out_size, void* d_ws, size_t ws_size, hipStream_t stream) {
    static int grid = 0;
    if (grid == 0) {
        if (n_in != 15 || in_sizes[0] != M * D || out_size != M * D || ws_size < WS_END) { fprintf(stderr, "kernel_launch: unexpected shapes: n_in %d out %d ws %zu; nothing launched\n", n_in, out_size, ws_size); grid = -1; return; }
        int dev = 0, cus = 0;
        if (hipGetDevice(&dev) != hipSuccess || hipDeviceGetAttribute(&cus, hipDeviceAttributeMultiprocessorCount, dev) != hipSuccess) { grid = -1; return; }
        if (hipFuncSetAttribute((const void*)mk_fwd, hipFuncAttributeMaxDynamicSharedMemorySize, LDS_BYTES) != hipSuccess) { fprintf(stderr, "kernel_launch: hipFuncSetAttribute failed\n"); grid = -1; return; }
        int per_cu = 0;
        if (hipOccupancyMaxActiveBlocksPerMultiprocessor(&per_cu, (const void*)mk_fwd, NWAVES * 64, LDS_BYTES) != hipSuccess || per_cu < 1) fprintf(stderr, "kernel_launch: occupancy query says %d blocks per CU\n", per_cu);
        (void)hipGetLastError();
        grid = cus;
        if (grid != 256) fprintf(stderr, "kernel_launch: %d CUs; this kernel is built for 256\n", grid);
    }
    if (grid < 0) return;
    if (hipMemsetAsync((char*)d_ws + WS_CTL, 0, CTL_ZERO_BYTES, stream) != hipSuccess) return;
    Args a{};
    for (int i = 0; i < 15; ++i) a.in[i] = (const float*)d_in[i];
    a.out = (float*)d_out; a.ws = (unsigned char*)d_ws;
#if MK_ONE_LAUNCH
    a.ph_lo = 0; a.ph_hi = NPHASES; a.li = 0;
    hipLaunchKernelGGL(mk_fwd, dim3(grid), dim3(NWAVES * 64), LDS_BYTES, stream, a);
#else
    for (int ph = 0; ph < NPHASES; ++ph) { a.ph_lo = ph; a.ph_hi = ph + 1; a.li = ph; hipLaunchKernelGGL(mk_fwd, dim3(grid), dim3(NWAVES * 64), LDS_BYTES, stream, a); }
#endif
}
```

```cpp
#include <hip/hip_runtime.h>
#include <cstdio>
#include <cstdint>

#ifndef MK_ONE_LAUNCH
#define MK_ONE_LAUNCH 1
#endif

typedef unsigned short bf16;
constexpr int D = 1024, BATCH = 8, SEQ = 2048, M = BATCH * SEQ, DEPTH = 4, NH = 8, DH = 128, NG = 8, GD = 128, SGT = 128;
constexpr int OFF_Q = 0, OFF_K = 1024, OFF_V = 2048, OFF_O = 3072, OFF_ZA = 4096, OFF_I = 5120, OFF_F = 5128, OFF_U = 5136,
              OFF_VB = 6160, OFF_ZB = 7184, OFF_GA = 8208, OFF_GB = 9232, N_IN = 10256;
constexpr int NT1 = 41, NP1 = NT1 * 256;
constexpr float EPS = 1e-6f;

__host__ __device__ inline int src_col(int r) {
    const int t = r >> 8, j = r & 255;
    if (t < 8) return OFF_Q + r;
    if (t < 12) return OFF_V + (r - 2048);
    if (t < 20) return (j < 128 ? OFF_O : OFF_ZA) + 128 * (t - 12) + (j & 127);
    if (t < 28) return (j < 128 ? OFF_U : OFF_ZB) + 128 * (t - 20) + (j & 127);
    if (t < 32) return OFF_VB + (r - 7168);
    if (t < 36) return OFF_GA + (r - 8192);
    if (t < 40) return OFF_GB + (r - 9216);
    return j < 16 ? OFF_I + j : -1;
}

__device__ __forceinline__ float bf2f(bf16 v) { return __uint_as_float((unsigned)v << 16); }
__device__ __forceinline__ bf16 f2bf(float f) { unsigned u = __float_as_uint(f); return (bf16)((u + 0x7fffu + ((u >> 16) & 1u)) >> 16); }
__device__ __forceinline__ float fast_exp(float x) { return __builtin_amdgcn_exp2f(x * 1.4426950408889634f); }
__device__ __forceinline__ float sigmoidf_(float x) { return __builtin_amdgcn_rcpf(1.0f + fast_exp(-x)); }
__device__ __forceinline__ float siluf_(float x) { return x * sigmoidf_(x); }
__device__ __forceinline__ float geluf_(float x) { return x * sigmoidf_(1.5957691216057308f * (x + 0.044715f * x * x * x)); }
__device__ __forceinline__ float wave_sum(float v) {
#pragma unroll
    for (int o = 1; o < 64; o <<= 1) v += __shfl_xor(v, o);
    return v;
}

constexpr size_t MiB = 1u << 20;
constexpr size_t WS_CTL = 0, CTL_ZERO_BYTES = 1 * MiB;
constexpr size_t WS_WIN = 1 * MiB;
constexpr size_t WS_WIN_SZ = (size_t)DEPTH * NP1 * D * 2;
constexpr size_t WS_WAB = 84 * MiB;
constexpr size_t WS_WO = 100 * MiB;
constexpr size_t WS_B1 = 108 * MiB;
constexpr size_t WS_XN = 109 * MiB;
constexpr size_t WS_QK = 141 * MiB;
constexpr size_t WS_V  = 205 * MiB;
constexpr size_t WS_OZ = 237 * MiB;
constexpr size_t WS_UZ = 269 * MiB;
constexpr size_t WS_VB = 301 * MiB;
constexpr size_t WS_GA = 333 * MiB;
constexpr size_t WS_GB = 365 * MiB;
constexpr size_t WS_IF = 397 * MiB;
constexpr size_t WS_HA = 398 * MiB;
constexpr size_t WS_HB = 430 * MiB;
constexpr size_t WS_MG = 462 * MiB;
constexpr size_t WS_MGF = 494 * MiB;
constexpr size_t WS_OUTRAW = WS_MGF;
constexpr size_t WS_VBST = 558 * MiB;
constexpr size_t WS_END = 560 * MiB;
static_assert(WS_WIN + WS_WIN_SZ <= WS_WAB && WS_HB == WS_HA + 32 * MiB, "map");
namespace pg8 {
#define PG8_LAS __attribute__((address_space(3)))
typedef unsigned short bf16_t;
typedef short bf16x8 __attribute__((ext_vector_type(8)));
typedef float f32x4 __attribute__((ext_vector_type(4)));
typedef unsigned u32x4 __attribute__((ext_vector_type(4)));
constexpr int BM = 256, BK = 64, HALF = 128, HTB = HALF * BK * 2  , STAGE_BYTES = 8 * HTB, NXCD = 8, WGM = 8;

__host__ __device__ __forceinline__ int lds_byte(int r, int c) { const int st = (r >> 4) * 2 + (c >> 5), rr = r & 15, cc = c & 31, ob = rr * 64 + cc * 2; return st * 1024 + (ob ^ (((ob >> 9) & 1) << 5)); }
__host__ __device__ __forceinline__ void stage_rc(int b, int& R, int& C) { const int st = b / 1024, sb = b % 1024, swz = sb ^ (((sb >> 9) & 1) << 5); R = (st >> 1) * 16 + swz / 64; C = (st & 1) * 32 + (swz % 64) / 2; }
__host__ __device__ __forceinline__ int perm32(int rho) { const int n = rho >> 4, i = rho & 15; return 8 * (i >> 2) + 4 * n + (i & 3); }

struct Unit { int pm, pn; };
struct Gemm { const bf16_t* A; const bf16_t* Bt; int M, N, K; };

struct StaticOrder {
    int nM, nN, nwg, G, c;
    __host__ __device__ void init(int M, int N, int G_, int c_) { nM = M / BM; nN = N / BM; nwg = nM * nN; G = G_; c = c_; }
    __host__ __device__ bool next(int i, Unit& u) const {
        const long L = (long)i * G + c; if (L >= nwg) return false;
        int wgid = (int)L; { const int q = nwg / NXCD, r = nwg % NXCD, xcd = wgid % NXCD, off = wgid / NXCD; wgid = (xcd < r ? xcd * (q + 1) : r * (q + 1) + (xcd - r) * q) + off; }
        const int nig = WGM * nN, gid = wgid / nig, fm = gid * WGM, gsz = (nM - fm) < WGM ? (nM - fm) : WGM;
        u.pm = fm + ((wgid % nig) % gsz); u.pn = (wgid % nig) / gsz; return true;
    }
    __device__ __forceinline__ void a_ready(const Unit&) const {}
    __device__ __forceinline__ void done(const Unit&) const {}
    __device__ __forceinline__ size_t a_off(const Unit&) const { return 0; }
};

typedef float f32x2_ __attribute__((ext_vector_type(2)));
typedef __bf16 bf16x2_ __attribute__((ext_vector_type(2)));
__device__ __forceinline__ unsigned cvt_pk_bf16(float lo, float hi) { const f32x2_ v = {lo, hi}; const bf16x2_ b = __builtin_convertvector(v, bf16x2_); return __builtin_bit_cast(unsigned, b); }
__device__ __forceinline__ u32x4 pack8(const f32x4& a, const f32x4& b) { u32x4 w; w.x = cvt_pk_bf16(a[0], a[1]); w.y = cvt_pk_bf16(a[2], a[3]); w.z = cvt_pk_bf16(b[0], b[1]); w.w = cvt_pk_bf16(b[2], b[3]); return w; }
__device__ __forceinline__ f32x4 unpack_lo(unsigned x, unsigned y) { return (f32x4){__uint_as_float(x << 16), __uint_as_float(x & 0xffff0000u), __uint_as_float(y << 16), __uint_as_float(y & 0xffff0000u)}; }
template <int ACT> __device__ __forceinline__ f32x4 act4(f32x4 v) {
    if (ACT == 0) return v;
    f32x4 r;
#pragma unroll
    for (int i = 0; i < 4; ++i) r[i] = ACT == 1 ? geluf_(v[i]) : (ACT == 2 ? sigmoidf_(v[i]) : siluf_(v[i]));
    return r;
}

struct EpiP1 {
    static constexpr bool PERM = true, AFTER_DRAIN = false;
    const float* bias;
    bf16_t *QK, *V, *OZ, *UZ, *VB, *GA, *GB; float* IF; float* VBST;
    template <int ACT> __device__ __forceinline__ void plain(const f32x4 (&acc)[2][2][4][2], const f32x4 (&bv)[2][2], bf16_t* base, int ldc, int row0) const {
#pragma unroll
        for (int ai = 0; ai < 2; ++ai)
#pragma unroll
            for (int m = 0; m < 4; ++m) { bf16_t* rowp = base + (size_t)(row0 + ai * HALF + m * 16) * ldc;
#pragma unroll
                for (int bj = 0; bj < 2; ++bj) { const f32x4 v0 = act4<ACT>(acc[ai][bj][m][0] + bv[bj][0]), v1 = act4<ACT>(acc[ai][bj][m][1] + bv[bj][1]);
                    *(u32x4*)(rowp + bj * HALF) = pack8(v0, v1); } }
    }
    template <int ACT> __device__ __forceinline__ void paired(const f32x4 (&acc)[2][2][4][2], const f32x4 (&bv)[2][2], bf16_t* base, int row0) const {
#pragma unroll
        for (int ai = 0; ai < 2; ++ai)
#pragma unroll
            for (int m = 0; m < 4; ++m) { bf16_t* rowp = base + (size_t)(row0 + ai * HALF + m * 16) * D;
                const f32x4 a0 = act4<ACT>(acc[ai][0][m][0] + bv[0][0]), a1 = act4<ACT>(acc[ai][0][m][1] + bv[0][1]);
                const f32x4 z0 = act4<3>(acc[ai][1][m][0] + bv[1][0]), z1 = act4<3>(acc[ai][1][m][1] + bv[1][1]);
                *(u32x4*)rowp = pack8(a0 * z0, a1 * z1); }
    }
    __device__ __forceinline__ void operator()(const f32x4 (&acc)[2][2][4][2], const Unit& u, int wr, int wc, int fr, int fq) const {
        asm volatile("" : "+v"(fr), "+v"(fq));
        const int t = u.pn, row0 = u.pm * BM + wr * 64 + fr, cb = wc * 32 + 8 * fq;
        f32x4 bv[2][2];
#pragma unroll
        for (int bj = 0; bj < 2; ++bj)
#pragma unroll
            for (int n = 0; n < 2; ++n) bv[bj][n] = *(const f32x4*)(bias + t * 256 + bj * HALF + cb + 4 * n);
        if (t < 8) plain<0>(acc, bv, QK + 256 * t + cb, 2048, row0);
        else if (t < 12) plain<0>(acc, bv, V + 256 * (t - 8) + cb, D, row0);
        else if (t < 20) paired<2>(acc, bv, OZ + 128 * (t - 12) + cb, row0);
        else if (t < 28) paired<1>(acc, bv, UZ + 128 * (t - 20) + cb, row0);
        else if (t < 32) {
#pragma unroll
            for (int ai = 0; ai < 2; ++ai)
#pragma unroll
                for (int m = 0; m < 4; ++m) { const size_t row = (size_t)(row0 + ai * HALF + m * 16); bf16_t* rowp = VB + row * D + 256 * (t - 28) + cb;
                    float s1 = 0.f, s2 = 0.f;
#pragma unroll
                    for (int bj = 0; bj < 2; ++bj) { const f32x4 v0 = act4<1>(acc[ai][bj][m][0] + bv[bj][0]), v1 = act4<1>(acc[ai][bj][m][1] + bv[bj][1]);
                        s1 += ((v0[0] + v0[1]) + (v0[2] + v0[3])) + ((v1[0] + v1[1]) + (v1[2] + v1[3]));
                        s2 += ((v0[0] * v0[0] + v0[1] * v0[1]) + (v0[2] * v0[2] + v0[3] * v0[3])) + ((v1[0] * v1[0] + v1[1] * v1[1]) + (v1[2] * v1[2] + v1[3] * v1[3]));
                        *(u32x4*)(rowp + bj * HALF) = pack8(v0, v1); }
                    s1 += __shfl_xor(s1, 16); s1 += __shfl_xor(s1, 32); s2 += __shfl_xor(s2, 16); s2 += __shfl_xor(s2, 32);
                    if (fq == 0) { f32x2_ st = {s1, s2}; *(f32x2_*)(VBST + (row * 16 + (t - 28) * 4 + wc) * 2) = st; } }
        }
        else if (t < 36) plain<2>(acc, bv, GA + 256 * (t - 32) + cb, D, row0);
        else if (t < 40) plain<2>(acc, bv, GB + 256 * (t - 36) + cb, D, row0);
        else if (wc == 0 && fq < 2) {
#pragma unroll
            for (int ai = 0; ai < 2; ++ai)
#pragma unroll
                for (int m = 0; m < 4; ++m) { float* p = IF + (size_t)(row0 + ai * HALF + m * 16) * 16 + 8 * fq;
                    *(f32x4*)p = acc[ai][0][m][0] + bv[0][0]; *(f32x4*)(p + 4) = acc[ai][0][m][1] + bv[0][1]; }
        }
    }
};

struct EpiMerge {
    static constexpr bool PERM = true, AFTER_DRAIN = false;
    const bf16_t *GA, *GB; float* MGF; bf16_t* MG;
    __device__ __forceinline__ void operator()(const f32x4 (&acc)[2][2][4][2], const Unit& u, int wr, int wc, int fr, int fq) const {
        asm volatile("" : "+v"(fr), "+v"(fq));
        const bool second = u.pn >= 4; const int pn4 = u.pn & 3;
        const int row0 = u.pm * BM + wr * 64 + fr, col0 = pn4 * 256 + wc * 32 + 8 * fq;
        const bf16_t* G; if (second) G = GB; else G = GA;
        G += (size_t)row0 * D + col0; float* mp0 = MGF + (size_t)row0 * D + col0; bf16_t* mg0 = MG + (size_t)row0 * D + col0;
#pragma unroll
        for (int ai = 0; ai < 2; ++ai)
#pragma unroll
            for (int m = 0; m < 4; ++m) { const size_t o = (size_t)(ai * HALF + m * 16) * D;
#pragma unroll
                for (int bj = 0; bj < 2; ++bj) { const u32x4 g = *(const u32x4*)(G + o + bj * HALF);
                    const f32x4 g0 = unpack_lo(g.x, g.y), g1 = unpack_lo(g.z, g.w);
                    f32x4 v0 = acc[ai][bj][m][0] * g0, v1 = acc[ai][bj][m][1] * g1;
                    float* mp = mp0 + o + bj * HALF;
                    if (!second) { *(f32x4*)mp = v0; *(f32x4*)(mp + 4) = v1; }
                    else { v0 += *(const f32x4*)mp; v1 += *(const f32x4*)(mp + 4); *(u32x4*)(mg0 + o + bj * HALF) = pack8(v0, v1); } }
                asm volatile("" ::: "memory"); }
    }
};
struct PairOrder {
    int c; size_t hb_off;
    __device__ __forceinline__ bool next(int i, Unit& u) const {
        if (i >= 2) return false;
        u.pm = 8 * (c & 7) + ((c >> 3) & 7); u.pn = (c >> 6) + 4 * i; return true;
    }
    __device__ __forceinline__ void a_ready(const Unit&) const {}
    __device__ __forceinline__ void done(const Unit&) const {}
    __device__ __forceinline__ size_t a_off(const Unit& u) const { return u.pn >= 4 ? hb_off : 0; }
};
struct EpiF32 {
    static constexpr bool PERM = false, AFTER_DRAIN = false;
    float* C; int ldc;
    __device__ __forceinline__ void operator()(const f32x4 (&acc)[2][2][4][2], const Unit& u, int wr, int wc, int fr, int fq) const {
        asm volatile("" : "+v"(fr), "+v"(fq));
        const int row0 = u.pm * BM + wr * 64 + fr, col0 = u.pn * BM + wc * 32 + 4 * fq;
#pragma unroll
        for (int ai = 0; ai < 2; ++ai)
#pragma unroll
            for (int m = 0; m < 4; ++m) { float* rowp = C + (size_t)(row0 + ai * HALF + m * 16) * ldc + col0;
#pragma unroll
                for (int bj = 0; bj < 2; ++bj)
#pragma unroll
                    for (int n = 0; n < 2; ++n) *(f32x4*)(rowp + bj * HALF + n * 16) = acc[ai][bj][m][n]; }
    }
};

template <class Epi, class Sched, bool ALIGN_EPI = false, bool SP2 = false>
__device__ __forceinline__ void gemm_phase(PG8_LAS unsigned char* lds, const Gemm g, const Sched& S, const Epi& E) {
    int tid_ = threadIdx.x; asm volatile("" : "+v"(tid_));
    const int tid = tid_, wid = __builtin_amdgcn_readfirstlane(tid >> 6), lane = tid & 63, wr = wid >> 2, wc = wid & 3, fr = lane & 15, fq = lane >> 4;
    const int K = g.K, nt = K / BK;
    unsigned voffA[2], voffB[2];
#pragma unroll
    for (int i = 0; i < 2; ++i) { int R, C; stage_rc(tid * 16 + i * 8192, R, C); const int Rb = Epi::PERM ? ((R & ~31) + perm32(R & 31)) : R;
        voffA[i] = (unsigned)(R * K + C) * 2u; voffB[i] = (unsigned)(Rb * K + C) * 2u; }
    const size_t kstep = (size_t)(BK * 2);
    const size_t hstep = (size_t)HALF * K * 2;
    const size_t tstep = 2 * hstep;
    const unsigned ldsw = (unsigned)wid * 1024u;
    const int aoff = lds_byte(wr * 64 + fr, fq * 8), boff = lds_byte(wc * 32 + fr, fq * 8);
#define PG8_SA(b, h) (((b) * 2 + (h)) * HTB)
#define PG8_SB(b, h) ((4 + (b) * 2 + (h)) * HTB)
#define PG8_STAGE(bufoff, gbase, voff) do { _Pragma("unroll") for (int _i = 0; _i < 2; ++_i) \
        __builtin_amdgcn_global_load_lds((const unsigned*)((const char*)(gbase) + (voff)[_i]), (PG8_LAS unsigned*)(lds + (bufoff) + ldsw + _i * 8192), 16, 0, 0); } while (0)
#define PG8_LDA(dst, b, h) do { _Pragma("unroll") for (int m = 0; m < 4; ++m) _Pragma("unroll") for (int k = 0; k < 2; ++k) dst[m][k] = *(const PG8_LAS bf16x8*)(lds + PG8_SA(b, h) + aoff + m * 2048 + k * 1024); } while (0)
#define PG8_LDB(dst, b, h) do { _Pragma("unroll") for (int n = 0; n < 2; ++n) _Pragma("unroll") for (int k = 0; k < 2; ++k) dst[n][k] = *(const PG8_LAS bf16x8*)(lds + PG8_SB(b, h) + boff + n * 2048 + k * 1024); } while (0)
#define PG8_MMA(ai, bj, At, Bt) do { __builtin_amdgcn_s_setprio(1); _Pragma("unroll") for (int m = 0; m < 4; ++m) _Pragma("unroll") for (int n = 0; n < 2; ++n) _Pragma("unroll") for (int k = 0; k < 2; ++k) \
        acc[ai][bj][m][n] = __builtin_amdgcn_mfma_f32_16x16x32_bf16(Bt[n][k], At[m][k], acc[ai][bj][m][n], 0, 0, 0); __builtin_amdgcn_s_setprio(0); } while (0)
#define PG8_WAIT_V(n) asm volatile("s_waitcnt vmcnt(" #n ")" ::: "memory")
#define PG8_WAIT_L(n) asm volatile("s_waitcnt lgkmcnt(" #n ")" ::: "memory")
#define PG8_BAR __builtin_amdgcn_s_barrier()
#define PG8_SCHED __builtin_amdgcn_sched_barrier(0)
    Unit cur, nxt; int ui = 0;
    if (!S.next(0, cur)) return;
    f32x4 acc[2][2][4][2];
#pragma unroll
    for (int a = 0; a < 2; ++a)
#pragma unroll
        for (int b = 0; b < 2; ++b)
#pragma unroll
            for (int m = 0; m < 4; ++m)
#pragma unroll
                for (int n = 0; n < 2; ++n) acc[a][b][m][n] = (f32x4){0.f, 0.f, 0.f, 0.f};
    bf16x8 At[4][2], B0[2][2], B1[2][2];
    const char* cA = (const char*)g.A + S.a_off(cur) + (size_t)cur.pm * tstep; const char* cB = (const char*)g.Bt + (size_t)cur.pn * tstep;
    S.a_ready(cur);
    if constexpr (SP2) {
        PG8_STAGE(PG8_SB(0, 0), cB, voffB); PG8_STAGE(PG8_SB(0, 1), cB + hstep, voffB); PG8_STAGE(PG8_SA(0, 0), cA, voffA); PG8_STAGE(PG8_SA(0, 1), cA + hstep, voffA);
        if (wr == 1) PG8_BAR;
        PG8_WAIT_V(2); PG8_BAR;
        PG8_STAGE(PG8_SB(1, 0), cB + kstep, voffB); PG8_STAGE(PG8_SA(1, 0), cA + kstep, voffA); PG8_STAGE(PG8_SB(1, 1), cB + hstep + kstep, voffB);
        PG8_WAIT_V(6); PG8_BAR;
    } else {
        PG8_STAGE(PG8_SB(0, 0), cB, voffB); PG8_STAGE(PG8_SA(0, 0), cA, voffA); PG8_STAGE(PG8_SB(0, 1), cB + hstep, voffB); PG8_STAGE(PG8_SA(0, 1), cA + hstep, voffA);
        if (wr == 1) PG8_BAR;
        PG8_WAIT_V(4); PG8_BAR;
        PG8_STAGE(PG8_SB(1, 0), cB + kstep, voffB); PG8_STAGE(PG8_SA(1, 0), cA + kstep, voffA); PG8_STAGE(PG8_SB(1, 1), cB + hstep + kstep, voffB);
        PG8_WAIT_V(6); PG8_BAR;
    }
    for (;;) {
        const bool has_next = S.next(ui + 1, nxt);
        const char* nA = has_next ? (const char*)g.A + S.a_off(nxt) + (size_t)nxt.pm * tstep : cA; const char* nB = has_next ? (const char*)g.Bt + (size_t)nxt.pn * tstep : cB;
        for (int t = 0; t < nt; t += 2) {
            const bool last = (t == nt - 2);
            const char* a1 = cA + (size_t)(t + 1) * kstep;
            const char* a2 = last ? nA : cA + (size_t)(t + 2) * kstep; const char* b2 = last ? nB : cB + (size_t)(t + 2) * kstep;
            const char* a3 = a2 + kstep; const char* b3 = b2 + kstep;
            if (last && has_next) S.a_ready(nxt);
            if constexpr (SP2) {
            PG8_LDB(B0, 0, 0); PG8_LDB(B1, 0, 1); PG8_SCHED; PG8_LDA(At, 0, 0); PG8_STAGE(PG8_SA(1, 1), a1 + hstep, voffA);
            PG8_WAIT_V(8); PG8_WAIT_L(0); PG8_BAR; PG8_MMA(0, 0, At, B0); PG8_MMA(0, 1, At, B1); PG8_BAR; PG8_SCHED;
            PG8_LDA(At, 0, 1); PG8_STAGE(PG8_SB(0, 0), b2, voffB); PG8_STAGE(PG8_SB(0, 1), b2 + hstep, voffB); PG8_STAGE(PG8_SA(0, 0), a2, voffA);
            PG8_WAIT_V(8); PG8_WAIT_L(0); PG8_BAR; PG8_MMA(1, 0, At, B0); PG8_MMA(1, 1, At, B1); PG8_BAR; PG8_SCHED;
            PG8_LDB(B0, 1, 0); PG8_LDB(B1, 1, 1); PG8_SCHED; PG8_LDA(At, 1, 0); PG8_STAGE(PG8_SA(0, 1), a2 + hstep, voffA);
            PG8_WAIT_V(8); PG8_WAIT_L(0); PG8_BAR; PG8_MMA(0, 0, At, B0); PG8_MMA(0, 1, At, B1); PG8_BAR; PG8_SCHED;
            PG8_LDA(At, 1, 1); PG8_STAGE(PG8_SB(1, 0), b3, voffB); PG8_STAGE(PG8_SB(1, 1), b3 + hstep, voffB); PG8_STAGE(PG8_SA(1, 0), a3, voffA);
            PG8_WAIT_V(8); PG8_WAIT_L(0); PG8_BAR; PG8_MMA(1, 0, At, B0); PG8_MMA(1, 1, At, B1); PG8_BAR; PG8_SCHED;
            } else {
            PG8_LDB(B0, 0, 0); PG8_SCHED; PG8_LDA(At, 0, 0); PG8_STAGE(PG8_SA(1, 1), a1 + hstep, voffA);
            PG8_WAIT_L(8); PG8_BAR; PG8_WAIT_L(0); PG8_MMA(0, 0, At, B0); PG8_BAR; PG8_SCHED;
            PG8_LDB(B1, 0, 1); PG8_STAGE(PG8_SB(0, 0), b2, voffB);
            PG8_BAR; PG8_WAIT_L(0); PG8_MMA(0, 1, At, B1); PG8_BAR;
            PG8_LDA(At, 0, 1); PG8_STAGE(PG8_SA(0, 0), a2, voffA);
            PG8_BAR; PG8_WAIT_L(0); PG8_MMA(1, 0, At, B0); PG8_BAR; PG8_SCHED;
            PG8_STAGE(PG8_SB(0, 1), b2 + hstep, voffB);
            PG8_WAIT_V(6); PG8_BAR; PG8_MMA(1, 1, At, B1); PG8_BAR;
            PG8_LDB(B0, 1, 0); PG8_SCHED; PG8_LDA(At, 1, 0); PG8_STAGE(PG8_SA(0, 1), a2 + hstep, voffA);
            PG8_WAIT_L(8); PG8_BAR; PG8_WAIT_L(0); PG8_MMA(0, 0, At, B0); PG8_BAR; PG8_SCHED;
            PG8_LDB(B1, 1, 1); PG8_STAGE(PG8_SB(1, 0), b3, voffB);
            PG8_BAR; PG8_WAIT_L(0); PG8_MMA(0, 1, At, B1); PG8_BAR;
            PG8_LDA(At, 1, 1); PG8_STAGE(PG8_SA(1, 0), a3, voffA);
            PG8_BAR; PG8_WAIT_L(0); PG8_MMA(1, 0, At, B0); PG8_BAR; PG8_SCHED;
            PG8_STAGE(PG8_SB(1, 1), b3 + hstep, voffB);
            PG8_WAIT_V(6); PG8_BAR; PG8_MMA(1, 1, At, B1); PG8_BAR;
            }
        }
        if constexpr (ALIGN_EPI) { if (wr == 0) PG8_BAR; }
        if constexpr (!Epi::AFTER_DRAIN) { E(acc, cur, wr, wc, fr, fq); S.done(cur); }
        if (!has_next) break;
#pragma unroll
        for (int a = 0; a < 2; ++a)
#pragma unroll
            for (int b = 0; b < 2; ++b)
#pragma unroll
                for (int m = 0; m < 4; ++m)
#pragma unroll
                    for (int n = 0; n < 2; ++n) acc[a][b][m][n] = (f32x4){0.f, 0.f, 0.f, 0.f};
        cur = nxt; cA = nA; cB = nB; ++ui;
        if constexpr (ALIGN_EPI) { if (wr == 1) PG8_BAR; }
    }
    PG8_WAIT_V(0);
    if constexpr (!ALIGN_EPI) { if (wr == 0) PG8_BAR; }
    PG8_BAR;
    if constexpr (Epi::AFTER_DRAIN) { E.fused(acc, cur, wr, wc, fr, fq, lds, wid, lane); S.done(cur); }
#undef PG8_SA
#undef PG8_SB
#undef PG8_STAGE
#undef PG8_LDA
#undef PG8_LDB
#undef PG8_MMA
#undef PG8_WAIT_V
#undef PG8_WAIT_L
#undef PG8_BAR
#undef PG8_SCHED
}
}

constexpr int NWAVES = 8;
constexpr int RING_OFF = 0, RING_BYTES = 131072;
constexpr int LDSCTL_OFF = RING_BYTES, MISC_OFF = LDSCTL_OFF + 320;
constexpr int LDS_BYTES = 147456;
constexpr int CW_TMO = 0, CW_CODE = 1;
constexpr int CW_BAR = 4096;

#define GAS __attribute__((address_space(1)))
#define LAS __attribute__((address_space(3)))
typedef unsigned v4u __attribute__((ext_vector_type(4)));
typedef float f32x4 __attribute__((ext_vector_type(4)));
typedef GAS unsigned gu32;
typedef GAS unsigned long long gu64;
#define RLX_AGENT __ATOMIC_RELAXED, __HIP_MEMORY_SCOPE_AGENT
#define LDS_WAIT() asm volatile("s_waitcnt lgkmcnt(0)" ::: "memory")
#define VM_WAIT() asm volatile("s_waitcnt vmcnt(0)" ::: "memory")
__device__ __forceinline__ unsigned pk2(float lo, float hi) { return (unsigned)f2bf(lo) | ((unsigned)f2bf(hi) << 16); }

#define XB_TMO      128
#define XB_XCNT(j)  (256  + 64 * (j))
#define XB_XSUB(j)  (1280 + 64 * (j))
#define XB_XGEN(j)  (2304 + 64 * (j))
#define XB_TOP      3328
#define XB_TOPGEN   3392
#define XCD_BAR_WORDS 3456
#define XB_SPIN_CAP (1u << 18)

__device__ __forceinline__ unsigned xb_ld(unsigned* p)              { return __hip_atomic_load(p, __ATOMIC_RELAXED, __HIP_MEMORY_SCOPE_AGENT); }
__device__ __forceinline__ unsigned xb_add(unsigned* p, unsigned v) { return __hip_atomic_fetch_add(p, v, __ATOMIC_RELAXED, __HIP_MEMORY_SCOPE_AGENT); }
__device__ __forceinline__ unsigned xb_xcc_id() { return (unsigned)__builtin_amdgcn_s_getreg((3 << 11) | 20) & 0xFu; }
#define XB_SPIN(cond, bar) do { unsigned _sp = 0; while (cond) { __builtin_amdgcn_s_sleep(1); \
    if ((++_sp & 255u) == 0u) { if (xb_ld(&(bar)[XB_TMO])) break; if (_sp > XB_SPIN_CAP) { atomicAdd(&(bar)[XB_TMO], 1u); break; } } } } while (0)

struct XcdBarrier {
    unsigned* bar; unsigned x;
    volatile LAS unsigned* st;
};

__device__ __forceinline__ XcdBarrier xcd_barrier_post(unsigned* bar, volatile LAS unsigned* st) {
    XcdBarrier b; b.bar = bar; b.x = xb_xcc_id(); b.st = st;
    if (threadIdx.x == 0) (void)xb_add(&bar[XB_XCNT(b.x)], 1u);
    return b;
}
__device__ __forceinline__ void xcd_barrier_complete(unsigned* bar, unsigned x, unsigned& nloc, unsigned& nx) {
    const unsigned G = gridDim.x * gridDim.y * gridDim.z;
    unsigned sum, cnt, mine, sp = 0u;
    for (;;) {
        sum = 0u; cnt = 0u; mine = 0u;
#pragma unroll
        for (unsigned j = 0; j < 16; ++j) { const unsigned c = xb_ld(&bar[XB_XCNT(j)]); sum += c; cnt += (c > 0u) ? 1u : 0u; mine = (j == x) ? c : mine; }
        if (sum == G) break;
        __builtin_amdgcn_s_sleep(1);
        if ((++sp & 255u) == 0u) { if (xb_ld(&bar[XB_TMO])) break; if (sp > XB_SPIN_CAP) { atomicAdd(&bar[XB_TMO], 1u); break; } }
    }
    nloc = mine > 0u ? mine : 1u; nx = cnt > 0u ? cnt : 1u;
}

__device__ __forceinline__ void xcd_barrier(const XcdBarrier& b) {
    asm volatile("s_waitcnt vmcnt(0)" ::: "memory");
    __syncthreads();
    if (threadIdx.x == 0) {
        unsigned* bar = b.bar;
        __builtin_amdgcn_s_waitcnt(0);
        unsigned nloc = b.st[0], nx = b.st[1];
        if (nloc == 0u) { xcd_barrier_complete(bar, b.x, nloc, nx); b.st[0] = nloc; b.st[1] = nx; }
        const unsigned old = xb_add(&bar[XB_XSUB(b.x)], 1u);
        const unsigned gen = old / nloc;
        if (old + 1u == (gen + 1u) * nloc) {
            __builtin_amdgcn_fence(__ATOMIC_RELEASE, "agent");
            asm volatile("s_waitcnt vmcnt(0)" ::: "memory");
            const unsigned og = xb_add(&bar[XB_TOP], 1u);
            const unsigned tg = og / nx;
            if (og + 1u == (tg + 1u) * nx) xb_add(&bar[XB_TOPGEN], 1u);
            else XB_SPIN(xb_ld(&bar[XB_TOPGEN]) == tg, bar);
            __builtin_amdgcn_fence(__ATOMIC_ACQUIRE, "agent");
            xb_add(&bar[XB_XGEN(b.x)], 1u);
            asm volatile("s_waitcnt vmcnt(0)" ::: "memory");
        } else {
            XB_SPIN(xb_ld(&bar[XB_XGEN(b.x)]) == gen, bar);
            __builtin_amdgcn_fence(__ATOMIC_ACQUIRE, "agent");
            asm volatile("s_waitcnt vmcnt(0)" ::: "memory");
        }
    }
    __syncthreads();
}

struct Frame {
    LAS unsigned char* lds;
    volatile LAS unsigned* MISC;
    gu32* ctl;
    int tid, lane, wave, G;
    const float *x, *norm_pre, *norm_post, *w_in, *b_in, *conv_w, *conv_b, *mhw, *sgw, *sgb, *w_s, *b_s, *w_a, *w_b, *w_out;
    float* out;
    bf16 *WIN, *WAB, *WO; float* B1;
    bf16 *XN, *QK, *V, *OZ, *UZ, *VB, *GA, *GB, *HA, *HB, *MG; float *IF, *MGF, *OUTRAW, *VBST;
};

__device__ __forceinline__ void p0_transpose_item(const float* W, int ldw, int src_c0, int nvalid, bf16* WTrow0, int K, int k0, LAS float* scr, int lane) {
    const int n_ = lane & 31;
#pragma unroll 8
    for (int i = 0; i < 32; ++i) { const int kk = 2 * i + (lane >> 5); scr[kk * 33 + n_] = (n_ < nvalid) ? W[(size_t)(k0 + kk) * ldw + src_c0 + n_] : 0.f; }
    LDS_WAIT(); asm volatile("" ::: "memory");
    const int c = lane & 7;
#pragma unroll
    for (int j = 0; j < 4; ++j) { const int n = (lane >> 3) + 8 * j; const LAS float* s = scr + (8 * c) * 33 + n;
        v4u o; o.x = pk2(s[0 * 33], s[1 * 33]); o.y = pk2(s[2 * 33], s[3 * 33]); o.z = pk2(s[4 * 33], s[5 * 33]); o.w = pk2(s[6 * 33], s[7 * 33]);
        *(GAS v4u*)(WTrow0 + (size_t)n * K + k0 + 8 * c) = o; }
    LDS_WAIT(); asm volatile("" ::: "memory");
}
__device__ __forceinline__ void rms_row_to_bf16(const float* xrow, const float* w, bf16* orow, int lane) {
    const GAS f32x4* xr = (const GAS f32x4*)xrow + lane; const GAS f32x4* wr = (const GAS f32x4*)w + lane;
    f32x4 v[4]; float s = 0.f;
#pragma unroll
    for (int j = 0; j < 4; ++j) { v[j] = xr[64 * j]; s += (v[j].x * v[j].x + v[j].y * v[j].y) + (v[j].z * v[j].z + v[j].w * v[j].w); }
    const float rstd = rsqrtf(wave_sum(s) * (1.f / D) + EPS);
    GAS unsigned long long* o8 = (GAS unsigned long long*)orow + lane;
#pragma unroll
    for (int j = 0; j < 4; ++j) { const f32x4 ww = wr[64 * j];
        o8[64 * j] = (unsigned long long)pk2(v[j].x * rstd * ww.x, v[j].y * rstd * ww.y) | ((unsigned long long)pk2(v[j].z * rstd * ww.z, v[j].w * rstd * ww.w) << 32); }
}
__device__ __forceinline__ void p0_prologue(Frame& F) {
    LAS float* scr = (LAS float*)(F.lds + RING_OFF + F.wave * 16384);
    const int gw = blockIdx.x * NWAVES + F.wave, NGW = F.G * NWAVES;
    constexpr int I_IN = (D / 64) * (NP1 / 32), I_SQ = (D / 64) * (D / 32), I_L = I_IN + 3 * I_SQ, NITEMS = DEPTH * I_L;
    for (int it = gw; it < NITEMS; it += NGW) {
        const int l = it / I_L; int r = it - l * I_L;
        if (r < I_IN) { const int kb = r / (NP1 / 32), nb = r % (NP1 / 32), r0 = nb * 32; const int sc = src_col(r0);
            const int nvalid = sc < 0 ? 0 : ((r0 >> 8) == 40 ? 16 : 32);
            p0_transpose_item(F.w_in + (size_t)l * D * N_IN, N_IN, sc < 0 ? 0 : sc, nvalid, F.WIN + ((size_t)l * NP1 + r0) * D, D, kb * 64, scr, F.lane); continue; }
        r -= I_IN; const int which = r / I_SQ; r -= which * I_SQ;
        const int kb = r / (D / 32), nb = r % (D / 32);
        const float* W; bf16* WT;
        if (which == 0) { W = F.w_a; WT = F.WAB + (size_t)l * 2048 * D; } else if (which == 1) { W = F.w_b; WT = F.WAB + ((size_t)l * 2048 + 1024) * D; } else { W = F.w_out; WT = F.WO + (size_t)l * D * D; }
        W += (size_t)l * D * D;
        p0_transpose_item(W, D, nb * 32, 32, WT + (size_t)nb * 32 * D, D, kb * 64, scr, F.lane);
    }
    for (int i = blockIdx.x * 512 + F.tid; i < DEPTH * NP1; i += F.G * 512) { const int l = i / NP1, r = i - l * NP1; const int sc = src_col(r); F.B1[i] = sc >= 0 ? F.b_in[(size_t)l * N_IN + sc] : 0.f; }
    for (int m = gw; m < M; m += NGW) rms_row_to_bf16(F.x + (size_t)m * D, F.norm_pre, F.XN + (size_t)m * D, F.lane);
}

__device__ __forceinline__ void mlstm_simple(Frame& F, int bh, int l) {
    LAS float* sq = (LAS float*)F.lds; LAS float* sk = sq + 128; LAS float* sv = sk + 128; LAS float* red = sv + 128; LAS float* sred = red + 512;
    const int bb = bh >> 3, h = bh & 7, tid = F.tid, dq = tid >> 7, e = tid & 127;
    const float* conv_w = F.conv_w + (size_t)l * 4 * 2048; const float* conv_b = F.conv_b + (size_t)l * 2048;
    const int ch = (tid < 128) ? (h * 128 + tid) : (1024 + h * 128 + ((tid - 128) & 127));
    const float cw0 = conv_w[0 * 2048 + ch], cw1 = conv_w[1 * 2048 + ch], cw2 = conv_w[2 * 2048 + ch], cw3 = conv_w[3 * 2048 + ch], cb = conv_b[ch];
    float p1 = 0.f, p2 = 0.f, p3 = 0.f;
    float C[32];
#pragma unroll
    for (int i = 0; i < 32; ++i) C[i] = 0.f;
    float nst = 0.f;
    const float mw = F.mhw[(size_t)l * D + h * 128 + e];
    for (int t = 0; t < SEQ; ++t) {
        const size_t row = (size_t)bb * SEQ + t;
        if (tid < 256) {
            const float x0 = bf2f(F.QK[row * 2048 + ch]);
            const float y = siluf_(cb + cw0 * p3 + cw1 * p2 + cw2 * p1 + cw3 * x0);
            p3 = p2; p2 = p1; p1 = x0;
            if (tid < 128) sq[tid] = y; else sk[tid - 128] = y * 0.08838834764831845f;
        } else if (tid < 384) sv[tid - 256] = bf2f(F.V[row * D + h * 128 + (tid - 256)]);
        const float ig = __expf(F.IF[row * 16 + h]), fg = sigmoidf_(F.IF[row * 16 + 8 + h]);
        __syncthreads();
        const float ve = sv[e];
        float pn = 0.f;
#pragma unroll
        for (int i = 0; i < 32; ++i) { const int d = dq * 32 + i; C[i] = fg * C[i] + (ig * sk[d]) * ve; pn += sq[d] * C[i]; }
        float dpart = 0.f;
        if (tid < 128) { nst = fg * nst + ig * sk[tid]; dpart = sq[tid] * nst; }
        red[tid] = pn;
        const float dsum = wave_sum(dpart);
        if (F.lane == 0) sred[F.wave] = dsum;
        __syncthreads();
        const float den = sred[0] + sred[1];
        const float num = (red[e] + red[128 + e]) + (red[256 + e] + red[384 + e]);
        const float hv = num / fmaxf(fabsf(den), 1.0f);
        const float s1 = wave_sum(tid < 128 ? hv : 0.f);
        __syncthreads();
        if (F.lane == 0) sred[F.wave] = s1;
        __syncthreads();
        const float mean = (sred[0] + sred[1]) * (1.f / 128.f);
        const float dv = hv - mean;
        const float s2 = wave_sum(tid < 128 ? dv * dv : 0.f);
        __syncthreads();
        if (F.lane == 0) sred[F.wave] = s2;
        __syncthreads();
        const float var = (sred[0] + sred[1]) * (1.f / 128.f);
        if (tid < 128) {
            const float hn = dv * rsqrtf(var + EPS) * mw;
            F.HA[row * D + h * 128 + e] = f2bf(hn * bf2f(F.OZ[row * D + h * 128 + e]));
        }
        __syncthreads();
    }
}
namespace ml {
typedef short s16x8 __attribute__((ext_vector_type(8)));
typedef float f32x16 __attribute__((ext_vector_type(16)));
typedef float f32x4 __attribute__((ext_vector_type(4)));
typedef float f32x2 __attribute__((ext_vector_type(2)));
typedef unsigned u32x4 __attribute__((ext_vector_type(4)));
typedef unsigned u32x2 __attribute__((ext_vector_type(2)));
constexpr int QST = 136, KTS = 72, CTS = 136;
constexpr int O_QS = 0, O_KS = O_QS + 64 * QST * 2, O_KWT = O_KS + 64 * QST * 2, O_VT = O_KWT + 128 * KTS * 2, O_CT = O_VT + 128 * KTS * 2, O_PS = O_CT + 128 * CTS * 2,
              O_G = O_PS + 64 * KTS * 2, G_BUF = 1536  , O_NP = O_G + 2 * G_BUF, O_QN = O_NP + 2 * 512,
              O_RS = O_QN + 256, O_LN = O_RS + 512, O_MW = O_LN + 2048, O_CW = O_MW + 512, O_END = O_CW + 5120;
static_assert(O_END <= 131072, "mlstm LDS map");
__device__ __forceinline__ unsigned pkbf(float lo, float hi) { typedef __bf16 b2 __attribute__((ext_vector_type(2))); const f32x2 v = {lo, hi}; const b2 b = __builtin_convertvector(v, b2); return __builtin_bit_cast(unsigned, b); }
__device__ __forceinline__ float blo(unsigned x) { return __uint_as_float(x << 16); }
__device__ __forceinline__ float bhi(unsigned x) { return __uint_as_float(x & 0xffff0000u); }
__device__ __forceinline__ float scan_add(float v, int lane) {
#pragma unroll
    for (int o = 1; o < 64; o <<= 1) { const float u = __shfl_up(v, o); if (lane >= o) v += u; }
    return v;
}
__device__ __forceinline__ float scan_max(float v, int lane) {
#pragma unroll
    for (int o = 1; o < 64; o <<= 1) { const float u = __shfl_up(v, o); if (lane >= o) v = fmaxf(v, u); }
    return v;
}
__device__ __forceinline__ float wave_max(float v) {
#pragma unroll
    for (int o = 1; o < 64; o <<= 1) v = fmaxf(v, __shfl_xor(v, o));
    return v;
}
}

__device__ __forceinline__ void mlstm_mfma(Frame& F, int bh, int l) {
    using namespace ml;
    LAS unsigned char* L = F.lds;
    const int bb = bh >> 3, h = bh & 7, tid = F.tid, lane = F.lane, w = F.wave;
    const int r32 = lane & 31, h32 = lane >> 5;
    const size_t rowbase = (size_t)bb * SEQ;
    const int cT = tid >> 8, ccg = tid & 15, ctb = (tid >> 4) & 15;
    const int cch = cT * 1024 + h * 128 + 8 * ccg;
    for (int i = tid; i < 2 * 5 * 128; i += NWAVES * 64) { const int T_ = i / 640, j_ = (i / 128) % 5, c_ = i & 127; const int chn = T_ * 1024 + h * 128 + c_;
        ((LAS float*)(L + O_CW))[i] = j_ < 4 ? F.conv_w[(size_t)l * 4 * 2048 + j_ * 2048 + chn] : F.conv_b[(size_t)l * 2048 + chn]; }
    const int vcg = tid & 15, vtb = tid >> 4;
    const int n_et = w & 3, n_tt = w >> 2;
    if (tid < 128) ((LAS float*)(L + O_MW))[tid] = F.mhw[(size_t)l * D + h * 128 + tid];
    f32x16 Cacc[2];
#pragma unroll
    for (int j = 0; j < 2; ++j)
#pragma unroll
        for (int i = 0; i < 16; ++i) Cacc[j][i] = 0.f;
    const int u_dt = w >> 1, u_et0 = 2 * (w & 1);
    float m_state = 0.f;
    LAS float* NP = (LAS float*)(L + O_NP);
    if (tid < 256) NP[tid] = 0.f;
#define ML_GATES(NC) do { \
        LAS float* G_ = (LAS float*)(L + O_G + ((NC) & 1) * G_BUF); \
        const size_t row_ = rowbase + (size_t)(NC) * 64 + lane; \
        const float ip_ = F.IF[row_ * 16 + h], fp_ = F.IF[row_ * 16 + 8 + h]; \
        const float lf_ = fminf(fp_, 0.f) - __logf(1.f + __expf(-fabsf(fp_))); \
        const float b_ = scan_add(lf_, lane); \
        const float g_ = __shfl(b_, 63); \
        const float a_ = g_ - b_ + ip_; \
        const float m_loc_ = wave_max(a_); \
        const float m_new_ = fmaxf(g_ + m_state, m_loc_); \
        const float c_ = ip_ - b_; \
        const float pm_ = scan_max(c_, lane); \
        const float mu_ = fmaxf(m_state, pm_); \
        G_[lane] = c_; G_[64 + lane] = mu_; G_[128 + lane] = __expf(m_state - mu_); G_[192 + lane] = __expf(-(b_ + mu_)); G_[256 + lane] = __expf(a_ - m_new_); \
        if (lane == 0) G_[320] = __expf(g_ + m_state - m_new_); \
        m_state = m_new_; } while (0)
    u32x4 rq0, rq1, rq2, rq3, rq4, rq5, rq6, rv0, rv1;
#define ML_LDQ(R, I, NC) do { const int t_ = (NC) * 64 + 4 * ctb - 3 + (I); if (t_ >= 0) R = *(const u32x4*)(F.QK + (rowbase + t_) * 2048 + cch); else R = (u32x4){0u, 0u, 0u, 0u}; } while (0)
#define ML_PREFETCH(NC) do { ML_LDQ(rq0, 0, NC); ML_LDQ(rq1, 1, NC); ML_LDQ(rq2, 2, NC); ML_LDQ(rq3, 3, NC); ML_LDQ(rq4, 4, NC); ML_LDQ(rq5, 5, NC); ML_LDQ(rq6, 6, NC); \
        rv0 = *(const u32x4*)(F.V + (rowbase + (NC) * 64 + 2 * vtb) * D + h * 128 + 8 * vcg); rv1 = *(const u32x4*)(F.V + (rowbase + (NC) * 64 + 2 * vtb + 1) * D + h * 128 + 8 * vcg); } while (0)
    if (w == 7) ML_GATES(0);
    ML_PREFETCH(0);
    __syncthreads();

    for (int nc = 0; nc < SEQ / 64; ++nc) {
        LAS float* G = (LAS float*)(L + O_G + (nc & 1) * G_BUF);
        LAS float* NPc = NP + (nc & 1) * 128; LAS float* NPn = NP + ((nc & 1) ^ 1) * 128;
        {
            const unsigned rqa[7][4] = {{rq0.x, rq0.y, rq0.z, rq0.w}, {rq1.x, rq1.y, rq1.z, rq1.w}, {rq2.x, rq2.y, rq2.z, rq2.w}, {rq3.x, rq3.y, rq3.z, rq3.w},
                                        {rq4.x, rq4.y, rq4.z, rq4.w}, {rq5.x, rq5.y, rq5.z, rq5.w}, {rq6.x, rq6.y, rq6.z, rq6.w}};
            const int t0 = 4 * ctb;
            f32x4 wt = {1.f, 1.f, 1.f, 1.f};
            if (cT == 1) wt = *(const LAS f32x4*)(G + 256 + t0);
            const float osc = cT == 1 ? 0.08838834764831845f : 1.0f;
            unsigned orow_[4][4];
#pragma unroll
            for (int c2 = 0; c2 < 4; ++c2) {
                float xa[7], xb[7];
#pragma unroll
                for (int i = 0; i < 7; ++i) { xa[i] = blo(rqa[i][c2]); xb[i] = bhi(rqa[i][c2]); }
                float ya[4], yb[4];
                const LAS float* cwl = (const LAS float*)(L + O_CW) + cT * 640 + 8 * ccg + 2 * c2;
                const f32x2 w0 = *(const LAS f32x2*)cwl, w1 = *(const LAS f32x2*)(cwl + 128), w2 = *(const LAS f32x2*)(cwl + 256), w3 = *(const LAS f32x2*)(cwl + 384), wb = *(const LAS f32x2*)(cwl + 512);
#pragma unroll
                for (int i = 0; i < 4; ++i) {
                    const float za = wb.x + w0.x * xa[i] + w1.x * xa[i + 1] + w2.x * xa[i + 2] + w3.x * xa[i + 3];
                    const float zb = wb.y + w0.y * xb[i] + w1.y * xb[i + 1] + w2.y * xb[i + 2] + w3.y * xb[i + 3];
                    ya[i] = siluf_(za) * osc; yb[i] = siluf_(zb) * osc;
                    orow_[i][c2] = pkbf(ya[i], yb[i]);
                }
                if (cT == 1) {
                    u32x2 oa, ob; oa.x = pkbf(ya[0] * wt[0], ya[1] * wt[1]); oa.y = pkbf(ya[2] * wt[2], ya[3] * wt[3]); ob.x = pkbf(yb[0] * wt[0], yb[1] * wt[1]); ob.y = pkbf(yb[2] * wt[2], yb[3] * wt[3]);
                    *(LAS u32x2*)(L + O_KWT + ((8 * ccg + 2 * c2) * KTS + t0) * 2) = oa;
                    *(LAS u32x2*)(L + O_KWT + ((8 * ccg + 2 * c2 + 1) * KTS + t0) * 2) = ob;
                }
            }
#pragma unroll
            for (int i = 0; i < 4; ++i) { u32x4 o; o.x = orow_[i][0]; o.y = orow_[i][1]; o.z = orow_[i][2]; o.w = orow_[i][3];
                *(LAS u32x4*)(L + (cT == 0 ? O_QS : O_KS) + ((t0 + i) * QST + 8 * ccg) * 2) = o; }
            {
                const unsigned a0[4] = {rv0.x, rv0.y, rv0.z, rv0.w}, a1[4] = {rv1.x, rv1.y, rv1.z, rv1.w};
#pragma unroll
                for (int c2 = 0; c2 < 4; ++c2) {
                    const unsigned lo = (a0[c2] & 0xffffu) | (a1[c2] << 16), hi = (a0[c2] >> 16) | (a1[c2] & 0xffff0000u);
                    *(LAS unsigned*)(L + O_VT + ((8 * vcg + 2 * c2) * KTS + 2 * vtb) * 2) = lo;
                    *(LAS unsigned*)(L + O_VT + ((8 * vcg + 2 * c2 + 1) * KTS + 2 * vtb) * 2) = hi;
                }
            }
#pragma unroll
            for (int j = 0; j < 2; ++j)
#pragma unroll
                for (int g = 0; g < 4; ++g) { u32x2 o; o.x = pkbf(Cacc[j][4 * g], Cacc[j][4 * g + 1]); o.y = pkbf(Cacc[j][4 * g + 2], Cacc[j][4 * g + 3]);
                    *(LAS u32x2*)(L + O_CT + ((32 * (u_et0 + j) + r32) * CTS + 32 * u_dt + 8 * g + 4 * h32) * 2) = o; }
            if (nc + 1 < SEQ / 64) { ML_PREFETCH(nc + 1); if (w == 7) ML_GATES(nc + 1); }
        }
        __syncthreads();
        {
            const int t16 = w & 3, sh = w >> 2, fr = lane & 15, fq = lane >> 4;
            const int tS = 16 * t16 + fr;
            const float mu_t = G[64 + tS];
            float rsum = 0.f;
#pragma unroll
            for (int si = 0; si < 2; ++si) {
                const int s16 = 2 * sh + si;
                f32x4 acc = {0.f, 0.f, 0.f, 0.f};
                if (s16 <= t16) {
#pragma unroll
                    for (int ks = 0; ks < 4; ++ks) {
                        const s16x8 a = *(const LAS s16x8*)(L + O_KS + ((16 * s16 + fr) * QST + 32 * ks + 8 * fq) * 2);
                        const s16x8 b = *(const LAS s16x8*)(L + O_QS + ((16 * t16 + fr) * QST + 32 * ks + 8 * fq) * 2);
                        acc = __builtin_amdgcn_mfma_f32_16x16x32_bf16(a, b, acc, 0, 0, 0);
                    }
                    const f32x4 cs = *(const LAS f32x4*)(G + 16 * s16 + 4 * fq);
#pragma unroll
                    for (int i = 0; i < 4; ++i) { const int s = 16 * s16 + 4 * fq + i; const float p = (s <= tS) ? __expf(cs[i] - mu_t) * acc[i] : 0.f; acc[i] = p; rsum += p; }
                }
                u32x2 o; o.x = pkbf(acc[0], acc[1]); o.y = pkbf(acc[2], acc[3]);
                *(LAS u32x2*)(L + O_PS + (tS * KTS + 16 * s16 + 4 * fq) * 2) = o;
            }
            rsum += __shfl_xor(rsum, 16); rsum += __shfl_xor(rsum, 32);
            if (fq == 0) ((LAS float*)(L + O_RS))[tS * 2 + sh] = rsum;
            {
                const int t = tid >> 3, seg = tid & 7;
                const u32x4 qa = *(const LAS u32x4*)(L + O_QS + (t * QST + 16 * seg) * 2), qb = *(const LAS u32x4*)(L + O_QS + (t * QST + 16 * seg + 8) * 2);
                const LAS f32x4* np = (const LAS f32x4*)(NPc + 16 * seg);
                const f32x4 n0 = np[0], n1 = np[1], n2 = np[2], n3 = np[3];
                float s = blo(qa.x) * n0[0] + bhi(qa.x) * n0[1] + blo(qa.y) * n0[2] + bhi(qa.y) * n0[3] + blo(qa.z) * n1[0] + bhi(qa.z) * n1[1] + blo(qa.w) * n1[2] + bhi(qa.w) * n1[3]
                        + blo(qb.x) * n2[0] + bhi(qb.x) * n2[1] + blo(qb.y) * n2[2] + bhi(qb.y) * n2[3] + blo(qb.z) * n3[0] + bhi(qb.z) * n3[1] + blo(qb.w) * n3[2] + bhi(qb.w) * n3[3];
                s += __shfl_xor(s, 1); s += __shfl_xor(s, 2); s += __shfl_xor(s, 4);
                if (seg == 0) ((LAS float*)(L + O_QN))[t] = s;
            }
            const float decay = G[320];
#pragma unroll
            for (int j = 0; j < 2; ++j)
#pragma unroll
                for (int i = 0; i < 16; ++i) Cacc[j][i] *= decay;
#pragma unroll
            for (int ks = 0; ks < 4; ++ks) {
                const s16x8 a = *(const LAS s16x8*)(L + O_KWT + ((32 * u_dt + r32) * KTS + 16 * ks + 8 * h32) * 2);
#pragma unroll
                for (int j = 0; j < 2; ++j) { const s16x8 b = *(const LAS s16x8*)(L + O_VT + ((32 * (u_et0 + j) + r32) * KTS + 16 * ks + 8 * h32) * 2);
                    Cacc[j] = __builtin_amdgcn_mfma_f32_32x32x16_bf16(a, b, Cacc[j], 0, 0, 0); }
            }
            if (tid < 128) {
                float s = 0.f;
#pragma unroll
                for (int q8 = 0; q8 < 8; ++q8) { const u32x4 kk = *(const LAS u32x4*)(L + O_KWT + (tid * KTS + 8 * q8) * 2);
                    s += (blo(kk.x) + bhi(kk.x)) + (blo(kk.y) + bhi(kk.y)) + (blo(kk.z) + bhi(kk.z)) + (blo(kk.w) + bhi(kk.w)); }
                NPn[tid] = decay * NPc[tid] + s;
            }
        }
        u32x2 oz[4];
        const size_t orow = rowbase + (size_t)nc * 64 + 32 * n_tt + r32;
        const size_t ocol = (size_t)h * 128 + 32 * n_et + 4 * h32;
#pragma unroll
        for (int g = 0; g < 4; ++g) oz[g] = *(const u32x2*)(F.OZ + orow * D + ocol + 8 * g);
        __syncthreads();
        f32x16 acc;
#pragma unroll
        for (int i = 0; i < 16; ++i) acc[i] = 0.f;
        const int tN = 32 * n_tt + r32;
        {
#pragma unroll
            for (int ks = 0; ks < 8; ++ks) {
                const s16x8 a = *(const LAS s16x8*)(L + O_CT + ((32 * n_et + r32) * CTS + 16 * ks + 8 * h32) * 2);
                const s16x8 b = *(const LAS s16x8*)(L + O_QS + (tN * QST + 16 * ks + 8 * h32) * 2);
                acc = __builtin_amdgcn_mfma_f32_32x32x16_bf16(a, b, acc, 0, 0, 0);
            }
            const float iw = G[128 + tN];
#pragma unroll
            for (int i = 0; i < 16; ++i) acc[i] *= iw;
            const int nks = 2 * (n_tt + 1);
            for (int ks = 0; ks < nks; ++ks) {
                const s16x8 a = *(const LAS s16x8*)(L + O_VT + ((32 * n_et + r32) * KTS + 16 * ks + 8 * h32) * 2);
                const s16x8 b = *(const LAS s16x8*)(L + O_PS + (tN * KTS + 16 * ks + 8 * h32) * 2);
                acc = __builtin_amdgcn_mfma_f32_32x32x16_bf16(a, b, acc, 0, 0, 0);
            }
            const LAS float* RS = (const LAS float*)(L + O_RS);
            const float den = iw * ((const LAS float*)(L + O_QN))[tN] + RS[tN * 2] + RS[tN * 2 + 1];
            const float rden = 1.0f / fmaxf(fabsf(den), G[192 + tN]);
            float s1 = 0.f, s2 = 0.f;
#pragma unroll
            for (int i = 0; i < 16; ++i) { acc[i] *= rden; s1 += acc[i]; s2 += acc[i] * acc[i]; }
            s1 += __shfl_xor(s1, 32); s2 += __shfl_xor(s2, 32);
            if (h32 == 0) *(LAS f32x2*)(L + O_LN + (tN * 4 + n_et) * 8) = (f32x2){s1, s2};
        }
        __syncthreads();
        {
            const LAS f32x2* P4 = (const LAS f32x2*)(L + O_LN + tN * 32);
            const f32x2 p0 = P4[0], p1 = P4[1], p2 = P4[2], p3 = P4[3];
            const float mean = ((p0.x + p1.x) + (p2.x + p3.x)) * (1.f / 128.f);
            const float var = fmaxf(((p0.y + p1.y) + (p2.y + p3.y)) * (1.f / 128.f) - mean * mean, 0.f);
            const float rstd = rsqrtf(var + EPS);
#pragma unroll
            for (int g = 0; g < 4; ++g) {
                const f32x4 mwv = *(const LAS f32x4*)(L + O_MW + (32 * n_et + 8 * g + 4 * h32) * 4);
                const float mw[16] = {mwv[0], mwv[1], mwv[2], mwv[3], mwv[0], mwv[1], mwv[2], mwv[3], mwv[0], mwv[1], mwv[2], mwv[3], mwv[0], mwv[1], mwv[2], mwv[3]};
                const float o0 = (acc[4 * g] - mean) * rstd * mw[4 * g] * blo(oz[g].x), o1 = (acc[4 * g + 1] - mean) * rstd * mw[4 * g + 1] * bhi(oz[g].x);
                const float o2 = (acc[4 * g + 2] - mean) * rstd * mw[4 * g + 2] * blo(oz[g].y), o3 = (acc[4 * g + 3] - mean) * rstd * mw[4 * g + 3] * bhi(oz[g].y);
                u32x2 o; o.x = pkbf(o0, o1); o.y = pkbf(o2, o3);
                *(u32x2*)(F.HA + orow * D + ocol + 8 * g) = o;
            }
        }
    }
    __syncthreads();
}

namespace sg { constexpr int WST = 136, O_WB = 0, O_VN = O_WB + 128 * WST * 2, O_ST = O_VN + 128 * WST * 2, O_END = O_ST + 1024; }
__device__ __forceinline__ void sgu_mfma(Frame& F, int j, int nsg, int l) {
    using namespace ml;
    LAS unsigned char* L = F.lds;
    const int tid = F.tid, lane = F.lane, w = F.wave, r32 = lane & 31, h32 = lane >> 5;
    const int g = j & 7, idx = j >> 3, nper = nsg >> 3;
    {
        const int t = tid >> 2, s0 = (tid & 3) * 32;
        const float* Wg = F.w_s + (((size_t)l * NG + g) * SGT + t) * SGT + s0;
#pragma unroll
        for (int q = 0; q < 4; ++q) { const f32x4 a = *(const f32x4*)(Wg + 8 * q), b = *(const f32x4*)(Wg + 8 * q + 4); const int s = s0 + 8 * q;
            u32x4 o; o.x = pkbf(s <= t ? a[0] : 0.f, s + 1 <= t ? a[1] : 0.f); o.y = pkbf(s + 2 <= t ? a[2] : 0.f, s + 3 <= t ? a[3] : 0.f);
            o.z = pkbf(s + 4 <= t ? b[0] : 0.f, s + 5 <= t ? b[1] : 0.f); o.w = pkbf(s + 6 <= t ? b[2] : 0.f, s + 7 <= t ? b[3] : 0.f);
            *(LAS u32x4*)(L + sg::O_WB + (t * sg::WST + s) * 2) = o; }
    }
    const int fcg = tid & 15, fsb = tid >> 4;
    float nw[8], nb[8];
    {
        const float* pw = F.sgw + (size_t)l * D + g * 128 + 8 * fcg; const float* pb = F.sgb + (size_t)l * D + g * 128 + 8 * fcg;
        const f32x4 a = *(const f32x4*)pw, b = *(const f32x4*)(pw + 4), c = *(const f32x4*)pb, d = *(const f32x4*)(pb + 4);
        nw[0] = a[0]; nw[1] = a[1]; nw[2] = a[2]; nw[3] = a[3]; nw[4] = b[0]; nw[5] = b[1]; nw[6] = b[2]; nw[7] = b[3];
        nb[0] = c[0]; nb[1] = c[1]; nb[2] = c[2]; nb[3] = c[3]; nb[4] = d[0]; nb[5] = d[1]; nb[6] = d[2]; nb[7] = d[3];
    }
    const int ct = w & 3, ttA = w >> 2;
    for (int p = idx; p < BATCH * 16; p += nper) {
        const size_t row0 = (size_t)(p >> 4) * SEQ + (size_t)(p & 15) * SGT;
        if (tid < 128) {
            const f32x4* st = (const f32x4*)(F.VBST + (row0 + tid) * 32);
            float s1 = 0.f, s2 = 0.f;
#pragma unroll
            for (int q = 0; q < 8; ++q) { const f32x4 a = st[q]; s1 += a[0] + a[2]; s2 += a[1] + a[3]; }
            const float mean = s1 * (1.f / D), var = fmaxf(s2 * (1.f / D) - mean * mean, 0.f);
            *(LAS f32x2*)(L + sg::O_ST + tid * 8) = (f32x2){mean, rsqrtf(var + EPS)};
        }
        u32x4 rv[4];
#pragma unroll
        for (int i = 0; i < 4; ++i) rv[i] = *(const u32x4*)(F.VB + (row0 + 4 * fsb + i) * D + g * 128 + 8 * fcg);
        __syncthreads();
        {
            float mu[4], rs[4];
#pragma unroll
            for (int i = 0; i < 4; ++i) { const f32x2 st = *(const LAS f32x2*)(L + sg::O_ST + (4 * fsb + i) * 8); mu[i] = st.x; rs[i] = st.y; }
#pragma unroll
            for (int c2 = 0; c2 < 4; ++c2) {
                float ya[4], yb[4];
#pragma unroll
                for (int i = 0; i < 4; ++i) { const unsigned wd = c2 == 0 ? rv[i].x : (c2 == 1 ? rv[i].y : (c2 == 2 ? rv[i].z : rv[i].w));
                    ya[i] = (blo(wd) - mu[i]) * rs[i] * nw[2 * c2] + nb[2 * c2]; yb[i] = (bhi(wd) - mu[i]) * rs[i] * nw[2 * c2 + 1] + nb[2 * c2 + 1]; }
                u32x2 oa, ob; oa.x = pkbf(ya[0], ya[1]); oa.y = pkbf(ya[2], ya[3]); ob.x = pkbf(yb[0], yb[1]); ob.y = pkbf(yb[2], yb[3]);
                *(LAS u32x2*)(L + sg::O_VN + ((8 * fcg + 2 * c2) * sg::WST + 4 * fsb) * 2) = oa;
                *(LAS u32x2*)(L + sg::O_VN + ((8 * fcg + 2 * c2 + 1) * sg::WST + 4 * fsb) * 2) = ob;
            }
        }
        __syncthreads();
#pragma unroll
        for (int half = 0; half < 2; ++half) {
            const int tt = half == 0 ? ttA : 3 - ttA;
            const int t = 32 * tt + r32;
            const size_t orow = row0 + t; const size_t ocol = (size_t)g * 128 + 32 * ct + 4 * h32;
            u32x2 uz[4];
#pragma unroll
            for (int q = 0; q < 4; ++q) uz[q] = *(const u32x2*)(F.UZ + orow * D + ocol + 8 * q);
            const float bs = F.b_s[((size_t)l * NG + g) * SGT + t];
            f32x16 acc;
#pragma unroll
            for (int i = 0; i < 16; ++i) acc[i] = 0.f;
            const int nks = 2 * (tt + 1);
            for (int ks = 0; ks < nks; ++ks) {
                const s16x8 a = *(const LAS s16x8*)(L + sg::O_VN + ((32 * ct + r32) * sg::WST + 16 * ks + 8 * h32) * 2);
                const s16x8 b = *(const LAS s16x8*)(L + sg::O_WB + (t * sg::WST + 16 * ks + 8 * h32) * 2);
                acc = __builtin_amdgcn_mfma_f32_32x32x16_bf16(a, b, acc, 0, 0, 0);
            }
#pragma unroll
            for (int q = 0; q < 4; ++q) { u32x2 o; o.x = pkbf(blo(uz[q].x) * (acc[4 * q] + bs), bhi(uz[q].x) * (acc[4 * q + 1] + bs)); o.y = pkbf(blo(uz[q].y) * (acc[4 * q + 2] + bs), bhi(uz[q].y) * (acc[4 * q + 3] + bs));
                *(u32x2*)(F.HB + orow * D + ocol + 8 * q) = o; }
        }
        __syncthreads();
    }
}

__device__ __forceinline__ void sgu_simple(Frame& F, int u, int l) {
    LAS float* vn = (LAS float*)F.lds; LAS float* smu = vn + 128 * 64; LAS float* srs = smu + 128;
    const int ch = u & 1, g = (u >> 1) & 7, nb = (u >> 4) & 15, bb = u >> 8;
    const int lane = F.lane, wv = F.wave;
    const size_t row0 = (size_t)bb * SEQ + nb * SGT;
    for (int s = wv; s < 128; s += NWAVES) {
        const bf16* vr = F.VB + (row0 + s) * D;
        float x[16], sum = 0.f;
#pragma unroll
        for (int j = 0; j < 16; ++j) { x[j] = bf2f(vr[lane + 64 * j]); sum += x[j]; }
        const float mu = wave_sum(sum) * (1.f / D);
        float q = 0.f;
#pragma unroll
        for (int j = 0; j < 16; ++j) { const float d = x[j] - mu; q += d * d; }
        const float var = wave_sum(q) * (1.f / D);
        if (lane == 0) { smu[s] = mu; srs[s] = rsqrtf(var + EPS); }
    }
    __syncthreads();
    const int c = g * 128 + ch * 64 + lane;
    const float w_ = F.sgw[(size_t)l * D + c], b_ = F.sgb[(size_t)l * D + c];
    for (int s = wv; s < 128; s += NWAVES) vn[s * 64 + lane] = (bf2f(F.VB[(row0 + s) * D + c]) - smu[s]) * srs[s] * w_ + b_;
    __syncthreads();
    const float* W = F.w_s + ((size_t)l * NG + g) * SGT * SGT;
    const float* bs = F.b_s + ((size_t)l * NG + g) * SGT;
    for (int t = wv; t < 128; t += NWAVES) {
        float acc = 0.f;
        for (int s = 0; s <= t; ++s) acc += W[t * SGT + s] * vn[s * 64 + lane];
        acc += bs[t];
        F.HB[(row0 + t) * D + c] = f2bf(bf2f(F.UZ[(row0 + t) * D + c]) * acc);
    }
    __syncthreads();
}
__device__ __forceinline__ void p5_rows(Frame& F, int l) {
    const int gw = blockIdx.x * NWAVES + F.wave, NGW = F.G * NWAVES, lane = F.lane;
    const float* xin; if (l == 0) xin = F.x; else xin = F.out;
    const GAS f32x4* wpost = (const GAS f32x4*)(F.norm_post + (size_t)l * D) + lane;
    const GAS f32x4* wpre = (const GAS f32x4*)(F.norm_pre + (size_t)(l + 1 < DEPTH ? l + 1 : l) * D) + lane;
    for (int m = gw; m < M; m += NGW) {
        const GAS f32x4* orow = (const GAS f32x4*)(F.OUTRAW + (size_t)m * D) + lane; const GAS f32x4* xr = (const GAS f32x4*)(xin + (size_t)m * D) + lane;
        GAS f32x4* xo = (GAS f32x4*)(F.out + (size_t)m * D) + lane;
        f32x4 v[4], xv[4]; float s = 0.f;
#pragma unroll
        for (int j = 0; j < 4; ++j) { v[j] = orow[64 * j]; xv[j] = xr[64 * j]; s += (v[j].x * v[j].x + v[j].y * v[j].y) + (v[j].z * v[j].z + v[j].w * v[j].w); }
        const float rstd = rsqrtf(wave_sum(s) * (1.f / D) + EPS); float s2 = 0.f;
#pragma unroll
        for (int j = 0; j < 4; ++j) { xv[j] = xv[j] + v[j] * rstd * wpost[64 * j]; xo[64 * j] = xv[j]; s2 += (xv[j].x * xv[j].x + xv[j].y * xv[j].y) + (xv[j].z * xv[j].z + xv[j].w * xv[j].w); }
        if (l + 1 < DEPTH) {
            const float r2 = rsqrtf(wave_sum(s2) * (1.f / D) + EPS);
            GAS unsigned long long* o8 = (GAS unsigned long long*)(F.XN + (size_t)m * D) + lane;
#pragma unroll
            for (int j = 0; j < 4; ++j) { const f32x4 ww = wpre[64 * j];
                o8[64 * j] = (unsigned long long)pk2(xv[j].x * r2 * ww.x, xv[j].y * r2 * ww.y) | ((unsigned long long)pk2(xv[j].z * r2 * ww.z, xv[j].w * r2 * ww.w) << 32); }
        }
    }
}


#ifndef PG8_SP2
#define PG8_SP2 true
#endif
#ifndef PG8_ALIGN
#define PG8_ALIGN true
#endif
#ifndef SGU_SIMPLE
#define SGU_SIMPLE 0
#endif
#ifndef REPEAT_MASK
#define REPEAT_MASK 0
#endif
#ifndef MLSTM_SIMPLE
#define MLSTM_SIMPLE 0
#endif
#ifndef NAIVE_MASK
#define NAIVE_MASK 0
#endif
__device__ __forceinline__ void naive_tile(Frame& F, const bf16* A, const bf16* Bt, int row0, int col0, float (&acc)[2][16]) {
    LAS float* sA = (LAS float*)F.lds; LAS float* sB = sA + 64 * 33;
    const int tid = F.tid, tx = tid & 15, ty = tid >> 4;
#pragma unroll
    for (int i = 0; i < 2; ++i)
#pragma unroll
        for (int j = 0; j < 16; ++j) acc[i][j] = 0.f;
    for (int k0 = 0; k0 < D; k0 += 32) {
        for (int i = tid; i < 64 * 32; i += 512) { const int r = i >> 5, c = i & 31; sA[r * 33 + c] = bf2f(A[(size_t)(row0 + r) * D + k0 + c]); }
        for (int i = tid; i < 256 * 32; i += 512) { const int r = i >> 5, c = i & 31; sB[r * 33 + c] = bf2f(Bt[(size_t)(col0 + r) * D + k0 + c]); }
        __syncthreads();
#pragma unroll 4
        for (int kk = 0; kk < 32; ++kk) {
            float a[2], b[16];
#pragma unroll
            for (int i = 0; i < 2; ++i) a[i] = sA[(ty * 2 + i) * 33 + kk];
#pragma unroll
            for (int j = 0; j < 16; ++j) b[j] = sB[(tx + 16 * j) * 33 + kk];
#pragma unroll
            for (int i = 0; i < 2; ++i)
#pragma unroll
                for (int j = 0; j < 16; ++j) acc[i][j] += a[i] * b[j];
        }
        __syncthreads();
    }
}
__device__ __forceinline__ void naive_p1(Frame& F, int l) {
    const bf16* WT = F.WIN + (size_t)l * NP1 * D; const float* B1 = F.B1 + (size_t)l * NP1;
    const int tx = F.tid & 15, ty = F.tid >> 4;
    for (int it = blockIdx.x; it < (M / 64) * NT1; it += F.G) {
        const int t = it % NT1, row0 = (it / NT1) * 64, col0 = t * 256;
        float acc[2][16];
        naive_tile(F, F.XN, WT, row0, col0, acc);
#pragma unroll
        for (int i = 0; i < 2; ++i) { const size_t row = row0 + ty * 2 + i;
#pragma unroll
            for (int jj = 0; jj < 16; ++jj) { const int j = tx + 16 * jj; const float v = acc[i][jj] + B1[col0 + j];
                if (t < 8) F.QK[row * 2048 + col0 + j] = f2bf(v);
                else if (t < 12) F.V[row * D + (col0 - 2048) + j] = f2bf(v);
                else if (t < 28) { if (jj < 8) { const float v2 = acc[i][jj + 8] + B1[col0 + j + 128];
                        if (t < 20) F.OZ[row * D + 128 * (t - 12) + j] = f2bf(sigmoidf_(v) * siluf_(v2)); else F.UZ[row * D + 128 * (t - 20) + j] = f2bf(geluf_(v) * siluf_(v2)); } }
                else if (t < 32) F.VB[row * D + 256 * (t - 28) + j] = f2bf(geluf_(v));
                else if (t < 36) F.GA[row * D + 256 * (t - 32) + j] = f2bf(sigmoidf_(v));
                else if (t < 40) F.GB[row * D + 256 * (t - 36) + j] = f2bf(sigmoidf_(v));
                else { if (j < 16) F.IF[row * 16 + j] = v; } } }
    }
}
__device__ __forceinline__ void naive_p3(Frame& F, int l) {
    const bf16* WA = F.WAB + (size_t)l * 2048 * D; const bf16* WB = WA + (size_t)1024 * D;
    const int tx = F.tid & 15, ty = F.tid >> 4;
    for (int it = blockIdx.x; it < (M / 64) * 4; it += F.G) {
        const int row0 = (it >> 2) * 64, col0 = (it & 3) * 256;
        float acc[2][16], tmp[2][16];
        naive_tile(F, F.HA, WA, row0, col0, acc);
#pragma unroll
        for (int i = 0; i < 2; ++i)
#pragma unroll
            for (int jj = 0; jj < 16; ++jj) tmp[i][jj] = acc[i][jj] * bf2f(F.GA[(size_t)(row0 + ty * 2 + i) * D + col0 + tx + 16 * jj]);
        naive_tile(F, F.HB, WB, row0, col0, acc);
#pragma unroll
        for (int i = 0; i < 2; ++i)
#pragma unroll
            for (int jj = 0; jj < 16; ++jj) { const size_t o = (size_t)(row0 + ty * 2 + i) * D + col0 + tx + 16 * jj; F.MG[o] = f2bf(tmp[i][jj] + acc[i][jj] * bf2f(F.GB[o])); }
    }
}
__device__ __forceinline__ void naive_p4(Frame& F, int l) {
    const bf16* WO = F.WO + (size_t)l * D * D;
    const int tx = F.tid & 15, ty = F.tid >> 4;
    for (int it = blockIdx.x; it < (M / 64) * 4; it += F.G) {
        const int row0 = (it >> 2) * 64, col0 = (it & 3) * 256;
        float acc[2][16];
        naive_tile(F, F.MG, WO, row0, col0, acc);
#pragma unroll
        for (int i = 0; i < 2; ++i)
#pragma unroll
            for (int jj = 0; jj < 16; ++jj) F.OUTRAW[(size_t)(row0 + ty * 2 + i) * D + col0 + tx + 16 * jj] = acc[i][jj];
    }
}

struct Args { const float* in[15]; float* out; unsigned char* ws; int ph_lo, ph_hi, li, pad; };
constexpr int NPHASES = 1 + 5 * DEPTH;
#ifndef PHSEL
#define PHSEL 63
#endif
__global__ void __launch_bounds__(NWAVES * 64, 2) mk_fwd(Args args) {
    extern __shared__ __attribute__((aligned(16))) unsigned char lds[];
    Frame F;
    F.lds = (LAS unsigned char*)lds;
    F.MISC = (volatile LAS unsigned*)(F.lds + MISC_OFF);
    F.tid = threadIdx.x; F.lane = F.tid & 63; F.wave = __builtin_amdgcn_readfirstlane(F.tid >> 6); F.G = gridDim.x;
    unsigned char* ws = args.ws;
    F.ctl = (gu32*)(ws + WS_CTL);
    F.x = args.in[0]; F.norm_pre = args.in[1]; F.norm_post = args.in[2]; F.w_in = args.in[3]; F.b_in = args.in[4]; F.conv_w = args.in[5]; F.conv_b = args.in[6];
    F.mhw = args.in[7]; F.sgw = args.in[8]; F.sgb = args.in[9]; F.w_s = args.in[10]; F.b_s = args.in[11]; F.w_a = args.in[12]; F.w_b = args.in[13]; F.w_out = args.in[14];
    F.out = args.out;
    F.WIN = (bf16*)(ws + WS_WIN); F.WAB = (bf16*)(ws + WS_WAB); F.WO = (bf16*)(ws + WS_WO); F.B1 = (float*)(ws + WS_B1);
    F.XN = (bf16*)(ws + WS_XN); F.QK = (bf16*)(ws + WS_QK); F.V = (bf16*)(ws + WS_V); F.OZ = (bf16*)(ws + WS_OZ); F.UZ = (bf16*)(ws + WS_UZ); F.VB = (bf16*)(ws + WS_VB);
    F.GA = (bf16*)(ws + WS_GA); F.GB = (bf16*)(ws + WS_GB); F.HA = (bf16*)(ws + WS_HA); F.HB = (bf16*)(ws + WS_HB); F.MG = (bf16*)(ws + WS_MG);
    F.IF = (float*)(ws + WS_IF); F.MGF = (float*)(ws + WS_MGF); F.OUTRAW = (float*)(ws + WS_OUTRAW); F.VBST = (float*)(ws + WS_VBST);
    for (int u = F.tid; u < (LDS_BYTES - LDSCTL_OFF) / 4; u += NWAVES * 64) ((LAS unsigned*)(F.lds + LDSCTL_OFF))[u] = 0u;
    __syncthreads();
    const int lo = args.ph_lo, hi = args.ph_hi;
    XcdBarrier bar; bar.bar = (unsigned*)(F.ctl + CW_BAR); bar.x = 0; bar.st = nullptr;
    if (hi - lo > 1) bar = xcd_barrier_post((unsigned*)(F.ctl + CW_BAR), F.MISC + 8);

    for (int ph = lo; ph < hi; ++ph) {
        for (int rep_ = 0; rep_ < 2; ++rep_) {
        if (rep_ == 1) { const int sub_ = ph == 0 ? -1 : (ph - 1) % 5; const int bit_ = ph == 0 ? 1 : (sub_ == 0 ? 2 : (sub_ == 1 ? (blockIdx.x < 64 ? 4 : 8) : (sub_ == 2 ? 16 : (sub_ == 3 ? 32 : 0)))); if (!(REPEAT_MASK & bit_)) break; }
        { int t_ = threadIdx.x; asm volatile("" : "+v"(t_)); F.tid = t_; F.lane = t_ & 63; }
        if (ph == 0) { if (PHSEL & 1) p0_prologue(F); }
        else {
            const int l = (ph - 1) / 5, sub = (ph - 1) % 5;
            if (sub == 0 && (NAIVE_MASK & 1)) naive_p1(F, l);
            else if (sub == 2 && (NAIVE_MASK & 2)) naive_p3(F, l);
            else if (sub == 3 && (NAIVE_MASK & 4)) naive_p4(F, l);
            else if (sub == 0 && (PHSEL & 2)) {
                pg8::Gemm g{F.XN, F.WIN + (size_t)l * NP1 * D, M, NP1, D}; pg8::StaticOrder S; S.init(M, NP1, F.G, (int)blockIdx.x);
                pg8::EpiP1 E{F.B1 + (size_t)l * NP1, F.QK, F.V, F.OZ, F.UZ, F.VB, F.GA, F.GB, F.IF, F.VBST};
                pg8::gemm_phase<pg8::EpiP1, pg8::StaticOrder, PG8_ALIGN, PG8_SP2>(F.lds + RING_OFF, g, S, E);
            } else if (sub == 1 && (PHSEL & 4)) {
                if (blockIdx.x < 64) { if (MLSTM_SIMPLE) mlstm_simple(F, blockIdx.x, l); else mlstm_mfma(F, blockIdx.x, l); }
                else if (SGU_SIMPLE) { for (int u = blockIdx.x - 64; u < BATCH * 16 * NG * 2; u += F.G - 64) sgu_simple(F, u, l); }
                else sgu_mfma(F, blockIdx.x - 64, F.G - 64, l);
            } else if (sub == 2 && (PHSEL & 8)) {
                if (F.G == 256) {
                    pg8::Gemm g{F.HA, F.WAB + (size_t)l * 2048 * D, M, 2048, D}; pg8::PairOrder S{(int)blockIdx.x, (size_t)(WS_HB - WS_HA)};
                    pg8::EpiMerge E{F.GA, F.GB, F.MGF, F.MG};
                    pg8::gemm_phase<pg8::EpiMerge, pg8::PairOrder, PG8_ALIGN, PG8_SP2>(F.lds + RING_OFF, g, S, E);
                }
            } else if (sub == 3 && (PHSEL & 16)) {
                pg8::Gemm g{F.MG, F.WO + (size_t)l * D * D, M, D, D}; pg8::StaticOrder S; S.init(M, D, F.G, (int)blockIdx.x);
                pg8::EpiF32 E{F.OUTRAW, D};
                pg8::gemm_phase<pg8::EpiF32, pg8::StaticOrder, PG8_ALIGN, PG8_SP2>(F.lds + RING_OFF, g, S, E);
            } else if (sub == 4 && (PHSEL & 32)) p5_rows(F, l);
        }
        }
        if (ph + 1 < hi) xcd_barrier(bar);
    }
}

extern "C" void kernel_launch(void* const* d_in, const int* in_sizes, int n_in, void* d_out, int out_size, void* d_ws, size_t ws_size, hipStream_t stream) {
    static int grid = 0;
    if (grid == 0) {
        if (n_in != 15 || in_sizes[0] != M * D || out_size != M * D || ws_size < WS_END) { fprintf(stderr, "kernel_launch: unexpected shapes: n_in %d out %d ws %zu; nothing launched\n", n_in, out_size, ws_size); grid = -1; return; }
        int dev = 0, cus = 0;
        if (hipGetDevice(&dev) != hipSuccess || hipDeviceGetAttribute(&cus, hipDeviceAttributeMultiprocessorCount, dev) != hipSuccess) { grid = -1; return; }
        if (hipFuncSetAttribute((const void*)mk_fwd, hipFuncAttributeMaxDynamicSharedMemorySize, LDS_BYTES) != hipSuccess) { fprintf(stderr, "kernel_launch: hipFuncSetAttribute failed\n"); grid = -1; return; }
        int per_cu = 0;
        if (hipOccupancyMaxActiveBlocksPerMultiprocessor(&per_cu, (const void*)mk_fwd, NWAVES * 64, LDS_BYTES) != hipSuccess || per_cu < 1) fprintf(stderr, "kernel_launch: occupancy query says %d blocks per CU\n", per_cu);
        (void)hipGetLastError();
        grid = cus;
        if (grid != 256) fprintf(stderr, "kernel_launch: %d CUs; this kernel is built for 256\n", grid);
    }
    if (grid < 0) return;
    if (hipMemsetAsync((char*)d_ws + WS_CTL, 0, CTL_ZERO_BYTES, stream) != hipSuccess) return;
    Args a{};
    for (int i = 0; i < 15; ++i) a.in[i] = (const float*)d_in[i];
    a.out = (float*)d_out; a.ws = (unsigned char*)d_ws;
#if MK_ONE_LAUNCH
    a.ph_lo = 0; a.ph_hi = NPHASES; a.li = 0;
    hipLaunchKernelGGL(mk_fwd, dim3(grid), dim3(NWAVES * 64), LDS_BYTES, stream, a);
#else
    for (int ph = 0; ph < NPHASES; ++ph) { a.ph_lo = ph; a.ph_hi = ph + 1; a.li = ph; hipLaunchKernelGGL(mk_fwd, dim3(grid), dim3(NWAVES * 64), LDS_BYTES, stream, a); }
#endif
}
```

```cpp
#include <hip/hip_runtime.h>
#include <cstdio>
#include <cstdint>

#ifndef MK_ONE_LAUNCH
#define MK_ONE_LAUNCH 1
#endif

typedef unsigned short bf16;
constexpr int D = 1024, BATCH = 8, SEQ = 2048, M = BATCH * SEQ, DEPTH = 4, NH = 8, DH = 128, NG = 8, GD = 128, SGT = 128;
constexpr int OFF_Q = 0, OFF_K = 1024, OFF_V = 2048, OFF_O = 3072, OFF_ZA = 4096, OFF_I = 5120, OFF_F = 5128, OFF_U = 5136,
              OFF_VB = 6160, OFF_ZB = 7184, OFF_GA = 8208, OFF_GB = 9232, N_IN = 10256;
constexpr int NT1 = 41, NP1 = NT1 * 256;
constexpr float EPS = 1e-6f;

__host__ __device__ inline int src_col(int r) {
    const int t = r >> 8, j = r & 255;
    if (t < 8) return OFF_Q + r;
    if (t < 12) return OFF_V + (r - 2048);
    if (t < 20) return (j < 128 ? OFF_O : OFF_ZA) + 128 * (t - 12) + (j & 127);
    if (t < 28) return (j < 128 ? OFF_U : OFF_ZB) + 128 * (t - 20) + (j & 127);
    if (t < 32) return OFF_VB + (r - 7168);
    if (t < 36) return OFF_GA + (r - 8192);
    if (t < 40) return OFF_GB + (r - 9216);
    return j < 16 ? OFF_I + j : -1;
}

__device__ __forceinline__ float bf2f(bf16 v) { return __uint_as_float((unsigned)v << 16); }
__device__ __forceinline__ bf16 f2bf(float f) { unsigned u = __float_as_uint(f); return (bf16)((u + 0x7fffu + ((u >> 16) & 1u)) >> 16); }
__device__ __forceinline__ float fast_exp(float x) { return __builtin_amdgcn_exp2f(x * 1.4426950408889634f); }
__device__ __forceinline__ float sigmoidf_(float x) { return __builtin_amdgcn_rcpf(1.0f + fast_exp(-x)); }
__device__ __forceinline__ float siluf_(float x) { return x * sigmoidf_(x); }
__device__ __forceinline__ float geluf_(float x) { return x * sigmoidf_(1.5957691216057308f * (x + 0.044715f * x * x * x)); }
__device__ __forceinline__ float wave_sum(float v) {
#pragma unroll
    for (int o = 1; o < 64; o <<= 1) v += __shfl_xor(v, o);
    return v;
}

constexpr size_t MiB = 1u << 20;
constexpr size_t WS_CTL = 0, CTL_ZERO_BYTES = 1 * MiB;
constexpr size_t WS_WIN = 1 * MiB;
constexpr size_t WS_WIN_SZ = (size_t)DEPTH * NP1 * D * 2;
constexpr size_t WS_WAB = 84 * MiB;
constexpr size_t WS_WO = 100 * MiB;
constexpr size_t WS_B1 = 108 * MiB;
constexpr size_t WS_XN = 109 * MiB;
constexpr size_t WS_QK = 141 * MiB;
constexpr size_t WS_V  = 205 * MiB;
constexpr size_t WS_OZ = 237 * MiB;
constexpr size_t WS_UZ = 269 * MiB;
constexpr size_t WS_VB = 301 * MiB;
constexpr size_t WS_GA = 333 * MiB;
constexpr size_t WS_GB = 365 * MiB;
constexpr size_t WS_IF = 397 * MiB;
constexpr size_t WS_HA = 398 * MiB;
constexpr size_t WS_HB = 430 * MiB;
constexpr size_t WS_MG = 462 * MiB;
constexpr size_t WS_MGF = 494 * MiB;
constexpr size_t WS_OUTRAW = WS_MGF;
constexpr size_t WS_VBST = 558 * MiB;
constexpr size_t WS_END = 560 * MiB;
static_assert(WS_WIN + WS_WIN_SZ <= WS_WAB && WS_HB == WS_HA + 32 * MiB, "map");
namespace pg8 {
#define PG8_LAS __attribute__((address_space(3)))
typedef unsigned short bf16_t;
typedef short bf16x8 __attribute__((ext_vector_type(8)));
typedef float f32x4 __attribute__((ext_vector_type(4)));
typedef unsigned u32x4 __attribute__((ext_vector_type(4)));
constexpr int BM = 256, BK = 64, HALF = 128, HTB = HALF * BK * 2  , STAGE_BYTES = 8 * HTB, NXCD = 8, WGM = 8;

__host__ __device__ __forceinline__ int lds_byte(int r, int c) { const int st = (r >> 4) * 2 + (c >> 5), rr = r & 15, cc = c & 31, ob = rr * 64 + cc * 2; return st * 1024 + (ob ^ (((ob >> 9) & 1) << 5)); }
__host__ __device__ __forceinline__ void stage_rc(int b, int& R, int& C) { const int st = b / 1024, sb = b % 1024, swz = sb ^ (((sb >> 9) & 1) << 5); R = (st >> 1) * 16 + swz / 64; C = (st & 1) * 32 + (swz % 64) / 2; }
__host__ __device__ __forceinline__ int perm32(int rho) { const int n = rho >> 4, i = rho & 15; return 8 * (i >> 2) + 4 * n + (i & 3); }

struct Unit { int pm, pn; };
struct Gemm { const bf16_t* A; const bf16_t* Bt; int M, N, K; };

struct StaticOrder {
    int nM, nN, nwg, G, c;
    __host__ __device__ void init(int M, int N, int G_, int c_) { nM = M / BM; nN = N / BM; nwg = nM * nN; G = G_; c = c_; }
    __host__ __device__ bool next(int i, Unit& u) const {
        const long L = (long)i * G + c; if (L >= nwg) return false;
        int wgid = (int)L; { const int q = nwg / NXCD, r = nwg % NXCD, xcd = wgid % NXCD, off = wgid / NXCD; wgid = (xcd < r ? xcd * (q + 1) : r * (q + 1) + (xcd - r) * q) + off; }
        const int nig = WGM * nN, gid = wgid / nig, fm = gid * WGM, gsz = (nM - fm) < WGM ? (nM - fm) : WGM;
        u.pm = fm + ((wgid % nig) % gsz); u.pn = (wgid % nig) / gsz; return true;
    }
    __device__ __forceinline__ void a_ready(const Unit&) const {}
    __device__ __forceinline__ void done(const Unit&) const {}
    __device__ __forceinline__ size_t a_off(const Unit&) const { return 0; }
};

typedef float f32x2_ __attribute__((ext_vector_type(2)));
typedef __bf16 bf16x2_ __attribute__((ext_vector_type(2)));
__device__ __forceinline__ unsigned cvt_pk_bf16(float lo, float hi) { const f32x2_ v = {lo, hi}; const bf16x2_ b = __builtin_convertvector(v, bf16x2_); return __builtin_bit_cast(unsigned, b); }
__device__ __forceinline__ u32x4 pack8(const f32x4& a, const f32x4& b) { u32x4 w; w.x = cvt_pk_bf16(a[0], a[1]); w.y = cvt_pk_bf16(a[2], a[3]); w.z = cvt_pk_bf16(b[0], b[1]); w.w = cvt_pk_bf16(b[2], b[3]); return w; }
__device__ __forceinline__ f32x4 unpack_lo(unsigned x, unsigned y) { return (f32x4){__uint_as_float(x << 16), __uint_as_float(x & 0xffff0000u), __uint_as_float(y << 16), __uint_as_float(y & 0xffff0000u)}; }
template <int ACT> __device__ __forceinline__ f32x4 act4(f32x4 v) {
    if (ACT == 0) return v;
    f32x4 r;
#pragma unroll
    for (int i = 0; i < 4; ++i) r[i] = ACT == 1 ? geluf_(v[i]) : (ACT == 2 ? sigmoidf_(v[i]) : siluf_(v[i]));
    return r;
}

struct EpiP1 {
    static constexpr bool PERM = true, AFTER_DRAIN = false;
    const float* bias;
    bf16_t *QK, *V, *OZ, *UZ, *VB, *GA, *GB; float* IF; float* VBST;
    template <int ACT> __device__ __forceinline__ void plain(const f32x4 (&acc)[2][2][4][2], const f32x4 (&bv)[2][2], bf16_t* base, int ldc, int row0) const {
#pragma unroll
        for (int ai = 0; ai < 2; ++ai)
#pragma unroll
            for (int m = 0; m < 4; ++m) { bf16_t* rowp = base + (size_t)(row0 + ai * HALF + m * 16) * ldc;
#pragma unroll
                for (int bj = 0; bj < 2; ++bj) { const f32x4 v0 = act4<ACT>(acc[ai][bj][m][0] + bv[bj][0]), v1 = act4<ACT>(acc[ai][bj][m][1] + bv[bj][1]);
                    *(u32x4*)(rowp + bj * HALF) = pack8(v0, v1); } }
    }
    template <int ACT> __device__ __forceinline__ void paired(const f32x4 (&acc)[2][2][4][2], const f32x4 (&bv)[2][2], bf16_t* base, int row0) const {
#pragma unroll
        for (int ai = 0; ai < 2; ++ai)
#pragma unroll
            for (int m = 0; m < 4; ++m) { bf16_t* rowp = base + (size_t)(row0 + ai * HALF + m * 16) * D;
                const f32x4 a0 = act4<ACT>(acc[ai][0][m][0] + bv[0][0]), a1 = act4<ACT>(acc[ai][0][m][1] + bv[0][1]);
                const f32x4 z0 = act4<3>(acc[ai][1][m][0] + bv[1][0]), z1 = act4<3>(acc[ai][1][m][1] + bv[1][1]);
                *(u32x4*)rowp = pack8(a0 * z0, a1 * z1); }
    }
    __device__ __forceinline__ void operator()(const f32x4 (&acc)[2][2][4][2], const Unit& u, int wr, int wc, int fr, int fq) const {
        asm volatile("" : "+v"(fr), "+v"(fq));
        const int t = u.pn, row0 = u.pm * BM + wr * 64 + fr, cb = wc * 32 + 8 * fq;
        f32x4 bv[2][2];
#pragma unroll
        for (int bj = 0; bj < 2; ++bj)
#pragma unroll
            for (int n = 0; n < 2; ++n) bv[bj][n] = *(const f32x4*)(bias + t * 256 + bj * HALF + cb + 4 * n);
        if (t < 8) plain<0>(acc, bv, QK + 256 * t + cb, 2048, row0);
        else if (t < 12) plain<0>(acc, bv, V + 256 * (t - 8) + cb, D, row0);
        else if (t < 20) paired<2>(acc, bv, OZ + 128 * (t - 12) + cb, row0);
        else if (t < 28) paired<1>(acc, bv, UZ + 128 * (t - 20) + cb, row0);
        else if (t < 32) {
#pragma unroll
            for (int ai = 0; ai < 2; ++ai)
#pragma unroll
                for (int m = 0; m < 4; ++m) { const size_t row = (size_t)(row0 + ai * HALF + m * 16); bf16_t* rowp = VB + row * D + 256 * (t - 28) + cb;
                    float s1 = 0.f, s2 = 0.f;
#pragma unroll
                    for (int bj = 0; bj < 2; ++bj) { const f32x4 v0 = act4<1>(acc[ai][bj][m][0] + bv[bj][0]), v1 = act4<1>(acc[ai][bj][m][1] + bv[bj][1]);
                        s1 += ((v0[0] + v0[1]) + (v0[2] + v0[3])) + ((v1[0] + v1[1]) + (v1[2] + v1[3]));
                        s2 += ((v0[0] * v0[0] + v0[1] * v0[1]) + (v0[2] * v0[2] + v0[3] * v0[3])) + ((v1[0] * v1[0] + v1[1] * v1[1]) + (v1[2] * v1[2] + v1[3] * v1[3]));
                        *(u32x4*)(rowp + bj * HALF) = pack8(v0, v1); }
                    s1 += __shfl_xor(s1, 16); s1 += __shfl_xor(s1, 32); s2 += __shfl_xor(s2, 16); s2 += __shfl_xor(s2, 32);
                    if (fq == 0) { f32x2_ st = {s1, s2}; *(f32x2_*)(VBST + (row * 16 + (t - 28) * 4 + wc) * 2) = st; } }
        }
        else if (t < 36) plain<2>(acc, bv, GA + 256 * (t - 32) + cb, D, row0);
        else if (t < 40) plain<2>(acc, bv, GB + 256 * (t - 36) + cb, D, row0);
        else if (wc == 0 && fq < 2) {
#pragma unroll
            for (int ai = 0; ai < 2; ++ai)
#pragma unroll
                for (int m = 0; m < 4; ++m) { float* p = IF + (size_t)(row0 + ai * HALF + m * 16) * 16 + 8 * fq;
                    *(f32x4*)p = acc[ai][0][m][0] + bv[0][0]; *(f32x4*)(p + 4) = acc[ai][0][m][1] + bv[0][1]; }
        }
    }
};

struct EpiMerge {
    static constexpr bool PERM = true, AFTER_DRAIN = false;
    const bf16_t *GA, *GB; float* MGF; bf16_t* MG;
    __device__ __forceinline__ void operator()(const f32x4 (&acc)[2][2][4][2], const Unit& u, int wr, int wc, int fr, int fq) const {
        asm volatile("" : "+v"(fr), "+v"(fq));
        const bool second = u.pn >= 4; const int pn4 = u.pn & 3;
        const int row0 = u.pm * BM + wr * 64 + fr, col0 = pn4 * 256 + wc * 32 + 8 * fq;
        const bf16_t* G; if (second) G = GB; else G = GA;
        G += (size_t)row0 * D + col0; float* mp0 = MGF + (size_t)row0 * D + col0; bf16_t* mg0 = MG + (size_t)row0 * D + col0;
#pragma unroll
        for (int ai = 0; ai < 2; ++ai)
#pragma unroll
            for (int m = 0; m < 4; ++m) { const size_t o = (size_t)(ai * HALF + m * 16) * D;
#pragma unroll
                for (int bj = 0; bj < 2; ++bj) { const u32x4 g = *(const u32x4*)(G + o + bj * HALF);
                    const f32x4 g0 = unpack_lo(g.x, g.y), g1 = unpack_lo(g.z, g.w);
                    f32x4 v0 = acc[ai][bj][m][0] * g0, v1 = acc[ai][bj][m][1] * g1;
                    float* mp = mp0 + o + bj * HALF;
                    if (!second) { *(f32x4*)mp = v0; *(f32x4*)(mp + 4) = v1; }
                    else { v0 += *(const f32x4*)mp; v1 += *(const f32x4*)(mp + 4); *(u32x4*)(mg0 + o + bj * HALF) = pack8(v0, v1); } }
                asm volatile("" ::: "memory"); }
    }
};
struct PairOrder {
    int c; size_t hb_off;
    __device__ __forceinline__ bool next(int i, Unit& u) const {
        if (i >= 2) return false;
        u.pm = 8 * (c & 7) + ((c >> 3) & 7); u.pn = (c >> 6) + 4 * i; return true;
    }
    __device__ __forceinline__ void a_ready(const Unit&) const {}
    __device__ __forceinline__ void done(const Unit&) const {}
    __device__ __forceinline__ size_t a_off(const Unit& u) const { return u.pn >= 4 ? hb_off : 0; }
};
struct EpiF32 {
    static constexpr bool PERM = false, AFTER_DRAIN = false;
    float* C; int ldc;
    __device__ __forceinline__ void operator()(const f32x4 (&acc)[2][2][4][2], const Unit& u, int wr, int wc, int fr, int fq) const {
        asm volatile("" : "+v"(fr), "+v"(fq));
        const int row0 = u.pm * BM + wr * 64 + fr, col0 = u.pn * BM + wc * 32 + 4 * fq;
#pragma unroll
        for (int ai = 0; ai < 2; ++ai)
#pragma unroll
            for (int m = 0; m < 4; ++m) { float* rowp = C + (size_t)(row0 + ai * HALF + m * 16) * ldc + col0;
#pragma unroll
                for (int bj = 0; bj < 2; ++bj)
#pragma unroll
                    for (int n = 0; n < 2; ++n) *(f32x4*)(rowp + bj * HALF + n * 16) = acc[ai][bj][m][n]; }
    }
};

template <class Epi, class Sched, bool ALIGN_EPI = false, bool SP2 = false>
__device__ __forceinline__ void gemm_phase(PG8_LAS unsigned char* lds, const Gemm g, const Sched& S, const Epi& E) {
    int tid_ = threadIdx.x; asm volatile("" : "+v"(tid_));
    const int tid = tid_, wid = __builtin_amdgcn_readfirstlane(tid >> 6), lane = tid & 63, wr = wid >> 2, wc = wid & 3, fr = lane & 15, fq = lane >> 4;
    const int K = g.K, nt = K / BK;
    unsigned voffA[2], voffB[2];
#pragma unroll
    for (int i = 0; i < 2; ++i) { int R, C; stage_rc(tid * 16 + i * 8192, R, C); const int Rb = Epi::PERM ? ((R & ~31) + perm32(R & 31)) : R;
        voffA[i] = (unsigned)(R * K + C) * 2u; voffB[i] = (unsigned)(Rb * K + C) * 2u; }
    const size_t kstep = (size_t)(BK * 2);
    const size_t hstep = (size_t)HALF * K * 2;
    const size_t tstep = 2 * hstep;
    const unsigned ldsw = (unsigned)wid * 1024u;
    const int aoff = lds_byte(wr * 64 + fr, fq * 8), boff = lds_byte(wc * 32 + fr, fq * 8);
#define PG8_SA(b, h) (((b) * 2 + (h)) * HTB)
#define PG8_SB(b, h) ((4 + (b) * 2 + (h)) * HTB)
#define PG8_STAGE(bufoff, gbase, voff) do { _Pragma("unroll") for (int _i = 0; _i < 2; ++_i) \
        __builtin_amdgcn_global_load_lds((const unsigned*)((const char*)(gbase) + (voff)[_i]), (PG8_LAS unsigned*)(lds + (bufoff) + ldsw + _i * 8192), 16, 0, 0); } while (0)
#define PG8_LDA(dst, b, h) do { _Pragma("unroll") for (int m = 0; m < 4; ++m) _Pragma("unroll") for (int k = 0; k < 2; ++k) dst[m][k] = *(const PG8_LAS bf16x8*)(lds + PG8_SA(b, h) + aoff + m * 2048 + k * 1024); } while (0)
#define PG8_LDB(dst, b, h) do { _Pragma("unroll") for (int n = 0; n < 2; ++n) _Pragma("unroll") for (int k = 0; k < 2; ++k) dst[n][k] = *(const PG8_LAS bf16x8*)(lds + PG8_SB(b, h) + boff + n * 2048 + k * 1024); } while (0)
#define PG8_MMA(ai, bj, At, Bt) do { __builtin_amdgcn_s_setprio(1); _Pragma("unroll") for (int m = 0; m < 4; ++m) _Pragma("unroll") for (int n = 0; n < 2; ++n) _Pragma("unroll") for (int k = 0; k < 2; ++k) \
        acc[ai][bj][m][n] = __builtin_amdgcn_mfma_f32_16x16x32_bf16(Bt[n][k], At[m][k], acc[ai][bj][m][n], 0, 0, 0); __builtin_amdgcn_s_setprio(0); } while (0)
#define PG8_WAIT_V(n) asm volatile("s_waitcnt vmcnt(" #n ")" ::: "memory")
#define PG8_WAIT_L(n) asm volatile("s_waitcnt lgkmcnt(" #n ")" ::: "memory")
#define PG8_BAR __builtin_amdgcn_s_barrier()
#define PG8_SCHED __builtin_amdgcn_sched_barrier(0)
    Unit cur, nxt; int ui = 0;
    if (!S.next(0, cur)) return;
    f32x4 acc[2][2][4][2];
#pragma unroll
    for (int a = 0; a < 2; ++a)
#pragma unroll
        for (int b = 0; b < 2; ++b)
#pragma unroll
            for (int m = 0; m < 4; ++m)
#pragma unroll
                for (int n = 0; n < 2; ++n) acc[a][b][m][n] = (f32x4){0.f, 0.f, 0.f, 0.f};
    bf16x8 At[4][2], B0[2][2], B1[2][2];
    const char* cA = (const char*)g.A + S.a_off(cur) + (size_t)cur.pm * tstep; const char* cB = (const char*)g.Bt + (size_t)cur.pn * tstep;
    S.a_ready(cur);
    if constexpr (SP2) {
        PG8_STAGE(PG8_SB(0, 0), cB, voffB); PG8_STAGE(PG8_SB(0, 1), cB + hstep, voffB); PG8_STAGE(PG8_SA(0, 0), cA, voffA); PG8_STAGE(PG8_SA(0, 1), cA + hstep, voffA);
        if (wr == 1) PG8_BAR;
        PG8_WAIT_V(2); PG8_BAR;
        PG8_STAGE(PG8_SB(1, 0), cB + kstep, voffB); PG8_STAGE(PG8_SA(1, 0), cA + kstep, voffA); PG8_STAGE(PG8_SB(1, 1), cB + hstep + kstep, voffB);
        PG8_WAIT_V(6); PG8_BAR;
    } else {
        PG8_STAGE(PG8_SB(0, 0), cB, voffB); PG8_STAGE(PG8_SA(0, 0), cA, voffA); PG8_STAGE(PG8_SB(0, 1), cB + hstep, voffB); PG8_STAGE(PG8_SA(0, 1), cA + hstep, voffA);
        if (wr == 1) PG8_BAR;
        PG8_WAIT_V(4); PG8_BAR;
        PG8_STAGE(PG8_SB(1, 0), cB + kstep, voffB); PG8_STAGE(PG8_SA(1, 0), cA + kstep, voffA); PG8_STAGE(PG8_SB(1, 1), cB + hstep + kstep, voffB);
        PG8_WAIT_V(6); PG8_BAR;
    }
    for (;;) {
        const bool has_next = S.next(ui + 1, nxt);
        const char* nA = has_next ? (const char*)g.A + S.a_off(nxt) + (size_t)nxt.pm * tstep : cA; const char* nB = has_next ? (const char*)g.Bt + (size_t)nxt.pn * tstep : cB;
        for (int t = 0; t < nt; t += 2) {
            const bool last = (t == nt - 2);
            const char* a1 = cA + (size_t)(t + 1) * kstep;
            const char* a2 = last ? nA : cA + (size_t)(t + 2) * kstep; const char* b2 = last ? nB : cB + (size_t)(t + 2) * kstep;
            const char* a3 = a2 + kstep; const char* b3 = b2 + kstep;
            if (last && has_next) S.a_ready(nxt);
            if constexpr (SP2) {
            PG8_LDB(B0, 0, 0); PG8_LDB(B1, 0, 1); PG8_SCHED; PG8_LDA(At, 0, 0); PG8_STAGE(PG8_SA(1, 1), a1 + hstep, voffA);
            PG8_WAIT_V(8); PG8_WAIT_L(0); PG8_BAR; PG8_MMA(0, 0, At, B0); PG8_MMA(0, 1, At, B1); PG8_BAR; PG8_SCHED;
            PG8_LDA(At, 0, 1); PG8_STAGE(PG8_SB(0, 0), b2, voffB); PG8_STAGE(PG8_SB(0, 1), b2 + hstep, voffB); PG8_STAGE(PG8_SA(0, 0), a2, voffA);
            PG8_WAIT_V(8); PG8_WAIT_L(0); PG8_BAR; PG8_MMA(1, 0, At, B0); PG8_MMA(1, 1, At, B1); PG8_BAR; PG8_SCHED;
            PG8_LDB(B0, 1, 0); PG8_LDB(B1, 1, 1); PG8_SCHED; PG8_LDA(At, 1, 0); PG8_STAGE(PG8_SA(0, 1), a2 + hstep, voffA);
            PG8_WAIT_V(8); PG8_WAIT_L(0); PG8_BAR; PG8_MMA(0, 0, At, B0); PG8_MMA(0, 1, At, B1); PG8_BAR; PG8_SCHED;
            PG8_LDA(At, 1, 1); PG8_STAGE(PG8_SB(1, 0), b3, voffB); PG8_STAGE(PG8_SB(1, 1), b3 + hstep, voffB); PG8_STAGE(PG8_SA(1, 0), a3, voffA);
            PG8_WAIT_V(8); PG8_WAIT_L(0); PG8_BAR; PG8_MMA(1, 0, At, B0); PG8_MMA(1, 1, At, B1); PG8_BAR; PG8_SCHED;
            } else {
            PG8_LDB(B0, 0, 0); PG8_SCHED; PG8_LDA(At, 0, 0); PG8_STAGE(PG8_SA(1, 1), a1 + hstep, voffA);
            PG8_WAIT_L(8); PG8_BAR; PG8_WAIT_L(0); PG8_MMA(0, 0, At, B0); PG8_BAR; PG8_SCHED;
            PG8_LDB(B1, 0, 1); PG8_STAGE(PG8_SB(0, 0), b2, voffB);
            PG8_BAR; PG8_WAIT_L(0); PG8_MMA(0, 1, At, B1); PG8_BAR;
            PG8_LDA(At, 0, 1); PG8_STAGE(PG8_SA(0, 0), a2, voffA);
            PG8_BAR; PG8_WAIT_L(0); PG8_MMA(1, 0, At, B0); PG8_BAR; PG8_SCHED;
            PG8_STAGE(PG8_SB(0, 1), b2 + hstep, voffB);
            PG8_WAIT_V(6); PG8_BAR; PG8_MMA(1, 1, At, B1); PG8_BAR;
            PG8_LDB(B0, 1, 0); PG8_SCHED; PG8_LDA(At, 1, 0); PG8_STAGE(PG8_SA(0, 1), a2 + hstep, voffA);
            PG8_WAIT_L(8); PG8_BAR; PG8_WAIT_L(0); PG8_MMA(0, 0, At, B0); PG8_BAR; PG8_SCHED;
            PG8_LDB(B1, 1, 1); PG8_STAGE(PG8_SB(1, 0), b3, voffB);
            PG8_BAR; PG8_WAIT_L(0); PG8_MMA(0, 1, At, B1); PG8_BAR;
            PG8_LDA(At, 1, 1); PG8_STAGE(PG8_SA(1, 0), a3, voffA);
            PG8_BAR; PG8_WAIT_L(0); PG8_MMA(1, 0, At, B0); PG8_BAR; PG8_SCHED;
            PG8_STAGE(PG8_SB(1, 1), b3 + hstep, voffB);
            PG8_WAIT_V(6); PG8_BAR; PG8_MMA(1, 1, At, B1); PG8_BAR;
            }
        }
        if constexpr (ALIGN_EPI) { if (wr == 0) PG8_BAR; }
        if constexpr (!Epi::AFTER_DRAIN) { E(acc, cur, wr, wc, fr, fq); S.done(cur); }
        if (!has_next) break;
#pragma unroll
        for (int a = 0; a < 2; ++a)
#pragma unroll
            for (int b = 0; b < 2; ++b)
#pragma unroll
                for (int m = 0; m < 4; ++m)
#pragma unroll
                    for (int n = 0; n < 2; ++n) acc[a][b][m][n] = (f32x4){0.f, 0.f, 0.f, 0.f};
        cur = nxt; cA = nA; cB = nB; ++ui;
        if constexpr (ALIGN_EPI) { if (wr == 1) PG8_BAR; }
    }
    PG8_WAIT_V(0);
    if constexpr (!ALIGN_EPI) { if (wr == 0) PG8_BAR; }
    PG8_BAR;
    if constexpr (Epi::AFTER_DRAIN) { E.fused(acc, cur, wr, wc, fr, fq, lds, wid, lane); S.done(cur); }
#undef PG8_SA
#undef PG8_SB
#undef PG8_STAGE
#undef PG8_LDA
#undef PG8_LDB
#undef PG8_MMA
#undef PG8_WAIT_V
#undef PG8_WAIT_L
#undef PG8_BAR
#undef PG8_SCHED
}
}

constexpr int NWAVES = 8;
constexpr int RING_OFF = 0, RING_BYTES = 131072;
constexpr int LDSCTL_OFF = RING_BYTES, MISC_OFF = LDSCTL_OFF + 320;
constexpr int LDS_BYTES = 147456;
constexpr int CW_TMO = 0, CW_CODE = 1;
constexpr int CW_BAR = 4096;

#define GAS __attribute__((address_space(1)))
#define LAS __attribute__((address_space(3)))
typedef unsigned v4u __attribute__((ext_vector_type(4)));
typedef float f32x4 __attribute__((ext_vector_type(4)));
typedef GAS unsigned gu32;
typedef GAS unsigned long long gu64;
#define RLX_AGENT __ATOMIC_RELAXED, __HIP_MEMORY_SCOPE_AGENT
#define LDS_WAIT() asm volatile("s_waitcnt lgkmcnt(0)" ::: "memory")
#define VM_WAIT() asm volatile("s_waitcnt vmcnt(0)" ::: "memory")
__device__ __forceinline__ unsigned pk2(float lo, float hi) { return (unsigned)f2bf(lo) | ((unsigned)f2bf(hi) << 16); }

#define XB_TMO      128
#define XB_XCNT(j)  (256  + 64 * (j))
#define XB_XSUB(j)  (1280 + 64 * (j))
#define XB_XGEN(j)  (2304 + 64 * (j))
#define XB_TOP      3328
#define XB_TOPGEN   3392
#define XCD_BAR_WORDS 3456
#define XB_SPIN_CAP (1u << 18)

__device__ __forceinline__ unsigned xb_ld(unsigned* p)              { return __hip_atomic_load(p, __ATOMIC_RELAXED, __HIP_MEMORY_SCOPE_AGENT); }
__device__ __forceinline__ unsigned xb_add(unsigned* p, unsigned v) { return __hip_atomic_fetch_add(p, v, __ATOMIC_RELAXED, __HIP_MEMORY_SCOPE_AGENT); }
__device__ __forceinline__ unsigned xb_xcc_id() { return (unsigned)__builtin_amdgcn_s_getreg((3 << 11) | 20) & 0xFu; }
#define XB_SPIN(cond, bar) do { unsigned _sp = 0; while (cond) { __builtin_amdgcn_s_sleep(1); \
    if ((++_sp & 255u) == 0u) { if (xb_ld(&(bar)[XB_TMO])) break; if (_sp > XB_SPIN_CAP) { atomicAdd(&(bar)[XB_TMO], 1u); break; } } } } while (0)

struct XcdBarrier {
    unsigned* bar; unsigned x;
    volatile LAS unsigned* st;
};

__device__ __forceinline__ XcdBarrier xcd_barrier_post(unsigned* bar, volatile LAS unsigned* st) {
    XcdBarrier b; b.bar = bar; b.x = xb_xcc_id(); b.st = st;
    if (threadIdx.x == 0) (void)xb_add(&bar[XB_XCNT(b.x)], 1u);
    return b;
}
__device__ __forceinline__ void xcd_barrier_complete(unsigned* bar, unsigned x, unsigned& nloc, unsigned& nx) {
    const unsigned G = gridDim.x * gridDim.y * gridDim.z;
    unsigned sum, cnt, mine, sp = 0u;
    for (;;) {
        sum = 0u; cnt = 0u; mine = 0u;
#pragma unroll
        for (unsigned j = 0; j < 16; ++j) { const unsigned c = xb_ld(&bar[XB_XCNT(j)]); sum += c; cnt += (c > 0u) ? 1u : 0u; mine = (j == x) ? c : mine; }
        if (sum == G) break;
        __builtin_amdgcn_s_sleep(1);
        if ((++sp & 255u) == 0u) { if (xb_ld(&bar[XB_TMO])) break; if (sp > XB_SPIN_CAP) { atomicAdd(&bar[XB_TMO], 1u); break; } }
    }
    nloc = mine > 0u ? mine : 1u; nx = cnt > 0u ? cnt : 1u;
}

__device__ __forceinline__ void xcd_barrier(const XcdBarrier& b) {
    asm volatile("s_waitcnt vmcnt(0)" ::: "memory");
    __syncthreads();
    if (threadIdx.x == 0) {
        unsigned* bar = b.bar;
        __builtin_amdgcn_s_waitcnt(0);
        unsigned nloc = b.st[0], nx = b.st[1];
        if (nloc == 0u) { xcd_barrier_complete(bar, b.x, nloc, nx); b.st[0] = nloc; b.st[1] = nx; }
        const unsigned old = xb_add(&bar[XB_XSUB(b.x)], 1u);
        const unsigned gen = old / nloc;
        if (old + 1u == (gen + 1u) * nloc) {
            __builtin_amdgcn_fence(__ATOMIC_RELEASE, "agent");
            asm volatile("s_waitcnt vmcnt(0)" ::: "memory");
            const unsigned og = xb_add(&bar[XB_TOP], 1u);
            const unsigned tg = og / nx;
            if (og + 1u == (tg + 1u) * nx) xb_add(&bar[XB_TOPGEN], 1u);
            else XB_SPIN(xb_ld(&bar[XB_TOPGEN]) == tg, bar);
            __builtin_amdgcn_fence(__ATOMIC_ACQUIRE, "agent");
            xb_add(&bar[XB_XGEN(b.x)], 1u);
            asm volatile("s_waitcnt vmcnt(0)" ::: "memory");
        } else {
            XB_SPIN(xb_ld(&bar[XB_XGEN(b.x)]) == gen, bar);
            __builtin_amdgcn_fence(__ATOMIC_ACQUIRE, "agent");
            asm volatile("s_waitcnt vmcnt(0)" ::: "memory");
        }
    }
    __syncthreads();
}

struct Frame {
    LAS unsigned char* lds;
    volatile LAS unsigned* MISC;
    gu32* ctl;
    int tid, lane, wave, G;
    const float *x, *norm_pre, *norm_post, *w_in, *b_in, *conv_w, *conv_b, *mhw, *sgw, *sgb, *w_s, *b_s, *w_a, *w_b, *w_out;
    float* out;
    bf16 *WIN, *WAB, *WO; float* B1;
    bf16 *XN, *QK, *V, *OZ, *UZ, *VB, *GA, *GB, *HA, *HB, *MG; float *IF, *MGF, *OUTRAW, *VBST;
};

__device__ __forceinline__ void p0_transpose_item(const float* W, int ldw, int src_c0, int nvalid, bf16* WTrow0, int K, int k0, LAS float* scr, int lane) {
    const int n_ = lane & 31;
#pragma unroll 8
    for (int i = 0; i < 32; ++i) { const int kk = 2 * i + (lane >> 5); scr[kk * 33 + n_] = (n_ < nvalid) ? W[(size_t)(k0 + kk) * ldw + src_c0 + n_] : 0.f; }
    LDS_WAIT(); asm volatile("" ::: "memory");
    const int c = lane & 7;
#pragma unroll
    for (int j = 0; j < 4; ++j) { const int n = (lane >> 3) + 8 * j; const LAS float* s = scr + (8 * c) * 33 + n;
        v4u o; o.x = pk2(s[0 * 33], s[1 * 33]); o.y = pk2(s[2 * 33], s[3 * 33]); o.z = pk2(s[4 * 33], s[5 * 33]); o.w = pk2(s[6 * 33], s[7 * 33]);
        *(GAS v4u*)(WTrow0 + (size_t)n * K + k0 + 8 * c) = o; }
    LDS_WAIT(); asm volatile("" ::: "memory");
}
__device__ __forceinline__ void rms_row_to_bf16(const float* xrow, const float* w, bf16* orow, int lane) {
    const GAS f32x4* xr = (const GAS f32x4*)xrow + lane; const GAS f32x4* wr = (const GAS f32x4*)w + lane;
    f32x4 v[4]; float s = 0.f;
#pragma unroll
    for (int j = 0; j < 4; ++j) { v[j] = xr[64 * j]; s += (v[j].x * v[j].x + v[j].y * v[j].y) + (v[j].z * v[j].z + v[j].w * v[j].w); }
    const float rstd = rsqrtf(wave_sum(s) * (1.f / D) + EPS);
    GAS unsigned long long* o8 = (GAS unsigned long long*)orow + lane;
#pragma unroll
    for (int j = 0; j < 4; ++j) { const f32x4 ww = wr[64 * j];
        o8[64 * j] = (unsigned long long)pk2(v[j].x * rstd * ww.x, v[j].y * rstd * ww.y) | ((unsigned long long)pk2(v[j].z * rstd * ww.z, v[j].w * rstd * ww.w) << 32); }
}
__device__ __forceinline__ void convert_layer_weights(Frame& F, int l, int gw, int NGW, int gt, int NGT) {
    LAS float* scr = (LAS float*)(F.lds + RING_OFF + F.wave * 16384);
    constexpr int I_IN = (D / 64) * (NP1 / 32), I_SQ = (D / 64) * (D / 32), I_L = I_IN + 3 * I_SQ;
    for (int it = gw; it < I_L; it += NGW) {
        int r = it;
        if (r < I_IN) { const int kb = r / (NP1 / 32), nb = r % (NP1 / 32), r0 = nb * 32; const int sc = src_col(r0);
            const int nvalid = sc < 0 ? 0 : ((r0 >> 8) == 40 ? 16 : 32);
            p0_transpose_item(F.w_in + (size_t)l * D * N_IN, N_IN, sc < 0 ? 0 : sc, nvalid, F.WIN + ((size_t)l * NP1 + r0) * D, D, kb * 64, scr, F.lane); continue; }
        r -= I_IN; const int which = r / I_SQ; r -= which * I_SQ;
        const int kb = r / (D / 32), nb = r % (D / 32);
        const float* W; bf16* WT;
        if (which == 0) { W = F.w_a; WT = F.WAB + (size_t)l * 2048 * D; } else if (which == 1) { W = F.w_b; WT = F.WAB + ((size_t)l * 2048 + 1024) * D; } else { W = F.w_out; WT = F.WO + (size_t)l * D * D; }
        W += (size_t)l * D * D;
        p0_transpose_item(W, D, nb * 32, 32, WT + (size_t)nb * 32 * D, D, kb * 64, scr, F.lane);
    }
    for (int i = gt; i < NP1; i += NGT) { const int sc = src_col(i); F.B1[(size_t)l * NP1 + i] = sc >= 0 ? F.b_in[(size_t)l * N_IN + sc] : 0.f; }
}
__device__ __forceinline__ void p0_prologue(Frame& F) {
    const int gw = blockIdx.x * NWAVES + F.wave, NGW = F.G * NWAVES;
    convert_layer_weights(F, 0, gw, NGW, blockIdx.x * 512 + F.tid, F.G * 512);
    for (int m = gw; m < M; m += NGW) rms_row_to_bf16(F.x + (size_t)m * D, F.norm_pre, F.XN + (size_t)m * D, F.lane);
}

__device__ __forceinline__ void mlstm_simple(Frame& F, int bh, int l) {
    LAS float* sq = (LAS float*)F.lds; LAS float* sk = sq + 128; LAS float* sv = sk + 128; LAS float* red = sv + 128; LAS float* sred = red + 512;
    const int bb = bh >> 3, h = bh & 7, tid = F.tid, dq = tid >> 7, e = tid & 127;
    const float* conv_w = F.conv_w + (size_t)l * 4 * 2048; const float* conv_b = F.conv_b + (size_t)l * 2048;
    const int ch = (tid < 128) ? (h * 128 + tid) : (1024 + h * 128 + ((tid - 128) & 127));
    const float cw0 = conv_w[0 * 2048 + ch], cw1 = conv_w[1 * 2048 + ch], cw2 = conv_w[2 * 2048 + ch], cw3 = conv_w[3 * 2048 + ch], cb = conv_b[ch];
    float p1 = 0.f, p2 = 0.f, p3 = 0.f;
    float C[32];
#pragma unroll
    for (int i = 0; i < 32; ++i) C[i] = 0.f;
    float nst = 0.f;
    const float mw = F.mhw[(size_t)l * D + h * 128 + e];
    for (int t = 0; t < SEQ; ++t) {
        const size_t row = (size_t)bb * SEQ + t;
        if (tid < 256) {
            const float x0 = bf2f(F.QK[row * 2048 + ch]);
            const float y = siluf_(cb + cw0 * p3 + cw1 * p2 + cw2 * p1 + cw3 * x0);
            p3 = p2; p2 = p1; p1 = x0;
            if (tid < 128) sq[tid] = y; else sk[tid - 128] = y * 0.08838834764831845f;
        } else if (tid < 384) sv[tid - 256] = bf2f(F.V[row * D + h * 128 + (tid - 256)]);
        const float ig = __expf(F.IF[row * 16 + h]), fg = sigmoidf_(F.IF[row * 16 + 8 + h]);
        __syncthreads();
        const float ve = sv[e];
        float pn = 0.f;
#pragma unroll
        for (int i = 0; i < 32; ++i) { const int d = dq * 32 + i; C[i] = fg * C[i] + (ig * sk[d]) * ve; pn += sq[d] * C[i]; }
        float dpart = 0.f;
        if (tid < 128) { nst = fg * nst + ig * sk[tid]; dpart = sq[tid] * nst; }
        red[tid] = pn;
        const float dsum = wave_sum(dpart);
        if (F.lane == 0) sred[F.wave] = dsum;
        __syncthreads();
        const float den = sred[0] + sred[1];
        const float num = (red[e] + red[128 + e]) + (red[256 + e] + red[384 + e]);
        const float hv = num / fmaxf(fabsf(den), 1.0f);
        const float s1 = wave_sum(tid < 128 ? hv : 0.f);
        __syncthreads();
        if (F.lane == 0) sred[F.wave] = s1;
        __syncthreads();
        const float mean = (sred[0] + sred[1]) * (1.f / 128.f);
        const float dv = hv - mean;
        const float s2 = wave_sum(tid < 128 ? dv * dv : 0.f);
        __syncthreads();
        if (F.lane == 0) sred[F.wave] = s2;
        __syncthreads();
        const float var = (sred[0] + sred[1]) * (1.f / 128.f);
        if (tid < 128) {
            const float hn = dv * rsqrtf(var + EPS) * mw;
            F.HA[row * D + h * 128 + e] = f2bf(hn * bf2f(F.OZ[row * D + h * 128 + e]));
        }
        __syncthreads();
    }
}
namespace ml {
typedef short s16x8 __attribute__((ext_vector_type(8)));
typedef short s16x4 __attribute__((ext_vector_type(4)));
typedef float f32x16 __attribute__((ext_vector_type(16)));
typedef float f32x4 __attribute__((ext_vector_type(4)));
typedef float f32x2 __attribute__((ext_vector_type(2)));
typedef unsigned u32x4 __attribute__((ext_vector_type(4)));
typedef unsigned u32x2 __attribute__((ext_vector_type(2)));
constexpr int CTS = 136, PST = 72;
constexpr int O_QS = 0, O_KS = 16384, O_VS = 32768, O_VW = 49152, O_CT = 65536, O_PS = O_CT + 128 * CTS * 2,
              O_G = O_PS + 64 * PST * 2, G_BUF = 1536  , O_NP = O_G + 2 * G_BUF, O_QN = O_NP + 2 * 512,
              O_RS = O_QN + 256, O_LN = O_RS + 512, O_MW = O_LN + 2048, O_CW = O_MW + 512, O_END = O_CW + 5120;
static_assert(O_END <= 131072, "mlstm LDS map");
__device__ __forceinline__ unsigned pkbf(float lo, float hi) { typedef __bf16 b2 __attribute__((ext_vector_type(2))); const f32x2 v = {lo, hi}; const b2 b = __builtin_convertvector(v, b2); return __builtin_bit_cast(unsigned, b); }
__device__ __forceinline__ float blo(unsigned x) { return __uint_as_float(x << 16); }
__device__ __forceinline__ float bhi(unsigned x) { return __uint_as_float(x & 0xffff0000u); }
__device__ __forceinline__ int off_b(int row, int ch) { return 256 * row + 16 * (ch ^ (((row & 3) << 2) | ((row >> 2) & 3))); }
__device__ __forceinline__ s16x8 tr_frag(LAS unsigned char* img, int lane, int c, int ks) {
    const int h = lane >> 5, blk = (lane >> 4) & 1, q = (lane & 15) >> 2, p = lane & 3;
    const int ch = 4 * c + 2 * blk + (p >> 1), r0 = 16 * ks + 8 * h + q;
    const s16x4 lo = __builtin_amdgcn_ds_read_tr16_b64_v4i16((LAS s16x4*)(img + off_b(r0, ch) + 8 * (p & 1)));
    const s16x4 hi = __builtin_amdgcn_ds_read_tr16_b64_v4i16((LAS s16x4*)(img + off_b(r0 + 4, ch) + 8 * (p & 1)));
    return (s16x8){lo[0], lo[1], lo[2], lo[3], hi[0], hi[1], hi[2], hi[3]};
}
template <int CTRL, int RM> __device__ __forceinline__ float dppf(float idv, float v) { return __builtin_bit_cast(float, __builtin_amdgcn_update_dpp(__builtin_bit_cast(int, idv), __builtin_bit_cast(int, v), CTRL, RM, 0xf, false)); }
__device__ __forceinline__ float scan_add(float v, int) {
    v += dppf<0x111, 0xf>(0.f, v); v += dppf<0x112, 0xf>(0.f, v); v += dppf<0x114, 0xf>(0.f, v); v += dppf<0x118, 0xf>(0.f, v);
    v += dppf<0x142, 0xa>(0.f, v); v += dppf<0x143, 0xc>(0.f, v); return v;
}
__device__ __forceinline__ float scan_max(float v, int) {
    const float ninf = -__builtin_inff();
    v = fmaxf(v, dppf<0x111, 0xf>(ninf, v)); v = fmaxf(v, dppf<0x112, 0xf>(ninf, v)); v = fmaxf(v, dppf<0x114, 0xf>(ninf, v)); v = fmaxf(v, dppf<0x118, 0xf>(ninf, v));
    v = fmaxf(v, dppf<0x142, 0xa>(ninf, v)); v = fmaxf(v, dppf<0x143, 0xc>(ninf, v)); return v;
}
__device__ __forceinline__ float lane63(float v) { return __builtin_bit_cast(float, __builtin_amdgcn_readlane(__builtin_bit_cast(int, v), 63)); }
}

__device__ __forceinline__ void mlstm_mfma(Frame& F, int bh, int l) {
    using namespace ml;
    LAS unsigned char* L = F.lds;
    const int bb = bh >> 3, h = bh & 7, tid = F.tid, lane = F.lane, w = F.wave;
    const int r32 = lane & 31, h32 = lane >> 5;
    const size_t rowbase = (size_t)bb * SEQ;
    const int cT = tid >> 8, ccg = tid & 15, ctb = (tid >> 4) & 15;
    const int cch = cT * 1024 + h * 128 + 8 * ccg;
    for (int i = tid; i < 2 * 5 * 128; i += NWAVES * 64) { const int T_ = i / 640, j_ = (i / 128) % 5, c_ = i & 127; const int chn = T_ * 1024 + h * 128 + c_;
        ((LAS float*)(L + O_CW))[i] = j_ < 4 ? F.conv_w[(size_t)l * 4 * 2048 + j_ * 2048 + chn] : F.conv_b[(size_t)l * 2048 + chn]; }
    const int vcg = tid & 15, vtb = tid >> 4;
    const int n_et = w & 3, n_tt = w >> 2;
    if (tid < 128) ((LAS float*)(L + O_MW))[tid] = F.mhw[(size_t)l * D + h * 128 + tid];
    f32x16 Cacc[2];
#pragma unroll
    for (int j = 0; j < 2; ++j)
#pragma unroll
        for (int i = 0; i < 16; ++i) Cacc[j][i] = 0.f;
    const int u_dt = w >> 1, u_et0 = 2 * (w & 1);
    float m_state = 0.f;
    float g_ip = 0.f, g_fp = 0.f;
    LAS float* NP = (LAS float*)(L + O_NP);
    if (tid < 256) NP[tid] = 0.f;
#define ML_LDIF(NC) do { const size_t row_ = rowbase + (size_t)(NC) * 64 + lane; g_ip = F.IF[row_ * 16 + h]; g_fp = F.IF[row_ * 16 + 8 + h]; } while (0)
#define ML_GATES(NC) do { \
        LAS float* G_ = (LAS float*)(L + O_G + ((NC) & 1) * G_BUF); \
        const float ip_ = g_ip, fp_ = g_fp; \
        const float lf_ = fminf(fp_, 0.f) - __logf(1.f + __expf(-fabsf(fp_))); \
        const float b_ = scan_add(lf_, lane); \
        const float g_ = lane63(b_); \
        const float a_ = g_ - b_ + ip_; \
        const float m_loc_ = lane63(scan_max(a_, lane)); \
        const float m_new_ = fmaxf(g_ + m_state, m_loc_); \
        const float c_ = ip_ - b_; \
        const float pm_ = scan_max(c_, lane); \
        const float mu_ = fmaxf(m_state, pm_); \
        G_[lane] = c_; G_[64 + lane] = mu_; G_[128 + lane] = __expf(m_state - mu_); G_[192 + lane] = __expf(-(b_ + mu_)); G_[256 + lane] = __expf(a_ - m_new_); \
        if (lane == 0) G_[320] = __expf(g_ + m_state - m_new_); \
        m_state = m_new_; } while (0)
    u32x4 rq0, rq1, rq2, rq3, rq4, rq5, rq6, rv0, rv1;
#define ML_LDQ(R, I, NC) do { const int t_ = (NC) * 64 + 4 * ctb - 3 + (I); if (t_ >= 0) R = *(const u32x4*)(F.QK + (rowbase + t_) * 2048 + cch); else R = (u32x4){0u, 0u, 0u, 0u}; } while (0)
#define ML_PREFETCH(NC) do { ML_LDQ(rq0, 0, NC); ML_LDQ(rq1, 1, NC); ML_LDQ(rq2, 2, NC); ML_LDQ(rq3, 3, NC); ML_LDQ(rq4, 4, NC); ML_LDQ(rq5, 5, NC); ML_LDQ(rq6, 6, NC); \
        rv0 = *(const u32x4*)(F.V + (rowbase + (NC) * 64 + 2 * vtb) * D + h * 128 + 8 * vcg); rv1 = *(const u32x4*)(F.V + (rowbase + (NC) * 64 + 2 * vtb + 1) * D + h * 128 + 8 * vcg); } while (0)
    if (w == 7) { ML_LDIF(0); ML_GATES(0); ML_LDIF(1); }
    ML_PREFETCH(0);
    __syncthreads();

    for (int nc = 0; nc < SEQ / 64; ++nc) {
        LAS float* G = (LAS float*)(L + O_G + (nc & 1) * G_BUF);
        LAS float* NPc = NP + (nc & 1) * 128; LAS float* NPn = NP + ((nc & 1) ^ 1) * 128;
        {
            const unsigned rqa[7][4] = {{rq0.x, rq0.y, rq0.z, rq0.w}, {rq1.x, rq1.y, rq1.z, rq1.w}, {rq2.x, rq2.y, rq2.z, rq2.w}, {rq3.x, rq3.y, rq3.z, rq3.w},
                                        {rq4.x, rq4.y, rq4.z, rq4.w}, {rq5.x, rq5.y, rq5.z, rq5.w}, {rq6.x, rq6.y, rq6.z, rq6.w}};
            const int t0 = 4 * ctb;
            const float osc = cT == 1 ? 0.08838834764831845f : 1.0f;
            unsigned orow_[4][4];
#pragma unroll
            for (int c2 = 0; c2 < 4; ++c2) {
                f32x2 xv[7];
#pragma unroll
                for (int i = 0; i < 7; ++i) xv[i] = (f32x2){blo(rqa[i][c2]), bhi(rqa[i][c2])};
                const LAS float* cwl = (const LAS float*)(L + O_CW) + cT * 640 + 8 * ccg + 2 * c2;
                const f32x2 w0 = *(const LAS f32x2*)cwl, w1 = *(const LAS f32x2*)(cwl + 128), w2 = *(const LAS f32x2*)(cwl + 256), w3 = *(const LAS f32x2*)(cwl + 384), wb = *(const LAS f32x2*)(cwl + 512);
#pragma unroll
                for (int i = 0; i < 4; ++i) {
                    const f32x2 z = wb + w0 * xv[i] + w1 * xv[i + 1] + w2 * xv[i + 2] + w3 * xv[i + 3];
                    const f32x2 ez = z * (-1.4426950408889634f);
                    f32x2 dn; dn.x = 1.0f + __builtin_amdgcn_exp2f(ez.x); dn.y = 1.0f + __builtin_amdgcn_exp2f(ez.y);
                    f32x2 rc; rc.x = __builtin_amdgcn_rcpf(dn.x); rc.y = __builtin_amdgcn_rcpf(dn.y);
                    const f32x2 y = z * rc * osc;
                    orow_[i][c2] = pkbf(y.x, y.y);
                }
            }
            LAS unsigned char* qk_img = L + (cT == 0 ? O_QS : O_KS);
#pragma unroll
            for (int i = 0; i < 4; ++i) { u32x4 o; o.x = orow_[i][0]; o.y = orow_[i][1]; o.z = orow_[i][2]; o.w = orow_[i][3];
                *(LAS u32x4*)(qk_img + off_b(t0 + i, ccg)) = o; }
            {
                const f32x2 wv = *(const LAS f32x2*)(G + 256 + 2 * vtb);
                *(LAS u32x4*)(L + O_VS + off_b(2 * vtb, vcg)) = rv0;
                *(LAS u32x4*)(L + O_VS + off_b(2 * vtb + 1, vcg)) = rv1;
                u32x4 a, b;
                a.x = pkbf(blo(rv0.x) * wv.x, bhi(rv0.x) * wv.x); a.y = pkbf(blo(rv0.y) * wv.x, bhi(rv0.y) * wv.x); a.z = pkbf(blo(rv0.z) * wv.x, bhi(rv0.z) * wv.x); a.w = pkbf(blo(rv0.w) * wv.x, bhi(rv0.w) * wv.x);
                b.x = pkbf(blo(rv1.x) * wv.y, bhi(rv1.x) * wv.y); b.y = pkbf(blo(rv1.y) * wv.y, bhi(rv1.y) * wv.y); b.z = pkbf(blo(rv1.z) * wv.y, bhi(rv1.z) * wv.y); b.w = pkbf(blo(rv1.w) * wv.y, bhi(rv1.w) * wv.y);
                *(LAS u32x4*)(L + O_VW + off_b(2 * vtb, vcg)) = a;
                *(LAS u32x4*)(L + O_VW + off_b(2 * vtb + 1, vcg)) = b;
            }
#pragma unroll
            for (int j = 0; j < 2; ++j)
#pragma unroll
                for (int g = 0; g < 4; ++g) { u32x2 o; o.x = pkbf(Cacc[j][4 * g], Cacc[j][4 * g + 1]); o.y = pkbf(Cacc[j][4 * g + 2], Cacc[j][4 * g + 3]);
                    *(LAS u32x2*)(L + O_CT + ((32 * (u_et0 + j) + r32) * CTS + 32 * u_dt + 8 * g + 4 * h32) * 2) = o; }
            if (nc + 1 < SEQ / 64) { ML_PREFETCH(nc + 1); if (w == 7) { ML_GATES(nc + 1); if (nc + 2 < SEQ / 64) ML_LDIF(nc + 2); } }
        }
        __syncthreads();
        {
            const int t16 = w & 3, sh = w >> 2, fr = lane & 15, fq = lane >> 4;
            const int tS = 16 * t16 + fr;
            const float mu_t = G[64 + tS];
            float rsum = 0.f;
#pragma unroll
            for (int si = 0; si < 2; ++si) {
                const int s16 = 2 * sh + si;
                f32x4 acc = {0.f, 0.f, 0.f, 0.f};
                if (s16 <= t16) {
                    s16x8 fa[4], fb[4];
#pragma unroll
                    for (int ks = 0; ks < 4; ++ks) { fa[ks] = *(const LAS s16x8*)(L + O_KS + off_b(16 * s16 + fr, 4 * ks + fq)); fb[ks] = *(const LAS s16x8*)(L + O_QS + off_b(16 * t16 + fr, 4 * ks + fq)); }
                    __builtin_amdgcn_sched_barrier(0);
#pragma unroll
                    for (int ks = 0; ks < 4; ++ks) acc = __builtin_amdgcn_mfma_f32_16x16x32_bf16(fa[ks], fb[ks], acc, 0, 0, 0);
                    const f32x4 cs = *(const LAS f32x4*)(G + 16 * s16 + 4 * fq);
#pragma unroll
                    for (int i = 0; i < 4; ++i) { const int s = 16 * s16 + 4 * fq + i; const float p = (s <= tS) ? __expf(cs[i] - mu_t) * acc[i] : 0.f; acc[i] = p; rsum += p; }
                }
                u32x2 o; o.x = pkbf(acc[0], acc[1]); o.y = pkbf(acc[2], acc[3]);
                *(LAS u32x2*)(L + O_PS + (tS * PST + 16 * s16 + 4 * fq) * 2) = o;
            }
            rsum += __shfl_xor(rsum, 16); rsum += __shfl_xor(rsum, 32);
            if (fq == 0) ((LAS float*)(L + O_RS))[tS * 2 + sh] = rsum;
            {
                const int t = tid >> 3, seg = tid & 7;
                const u32x4 qa = *(const LAS u32x4*)(L + O_QS + off_b(t, 2 * seg)), qb = *(const LAS u32x4*)(L + O_QS + off_b(t, 2 * seg + 1));
                const LAS f32x4* np = (const LAS f32x4*)(NPc + 16 * seg);
                const f32x4 n0 = np[0], n1 = np[1], n2 = np[2], n3 = np[3];
                float s = blo(qa.x) * n0[0] + bhi(qa.x) * n0[1] + blo(qa.y) * n0[2] + bhi(qa.y) * n0[3] + blo(qa.z) * n1[0] + bhi(qa.z) * n1[1] + blo(qa.w) * n1[2] + bhi(qa.w) * n1[3]
                        + blo(qb.x) * n2[0] + bhi(qb.x) * n2[1] + blo(qb.y) * n2[2] + bhi(qb.y) * n2[3] + blo(qb.z) * n3[0] + bhi(qb.z) * n3[1] + blo(qb.w) * n3[2] + bhi(qb.w) * n3[3];
                s += __shfl_xor(s, 1); s += __shfl_xor(s, 2); s += __shfl_xor(s, 4);
                if (seg == 0) ((LAS float*)(L + O_QN))[t] = s;
            }
            const float decay = G[320];
#pragma unroll
            for (int j = 0; j < 2; ++j)
#pragma unroll
                for (int i = 0; i < 16; ++i) Cacc[j][i] *= decay;
            f32x16 nacc;
#pragma unroll
            for (int i = 0; i < 16; ++i) nacc[i] = 0.f;
            s16x8 ua[4], ub0[4], ub1[4];
#pragma unroll
            for (int ks = 0; ks < 4; ++ks) { ua[ks] = tr_frag(L + O_KS, lane, u_dt, ks);
                ub0[ks] = tr_frag(L + O_VW, lane, u_et0, ks); ub1[ks] = tr_frag(L + O_VW, lane, u_et0 + 1, ks); }
            __builtin_amdgcn_sched_barrier(0);
#pragma unroll
            for (int ks = 0; ks < 4; ++ks) {
                const s16x8 a = ua[ks];
                Cacc[0] = __builtin_amdgcn_mfma_f32_32x32x16_bf16(a, ub0[ks], Cacc[0], 0, 0, 0);
                Cacc[1] = __builtin_amdgcn_mfma_f32_32x32x16_bf16(a, ub1[ks], Cacc[1], 0, 0, 0);
                if ((w & 1) == 0) {
                    const f32x4 wa = *(const LAS f32x4*)(G + 256 + 16 * ks + 8 * h32), wb2 = *(const LAS f32x4*)(G + 256 + 16 * ks + 8 * h32 + 4);
                    u32x4 wp; wp.x = pkbf(wa[0], wa[1]); wp.y = pkbf(wa[2], wa[3]); wp.z = pkbf(wb2[0], wb2[1]); wp.w = pkbf(wb2[2], wb2[3]);
                    if (r32 != 0) wp = (u32x4){0u, 0u, 0u, 0u};
                    nacc = __builtin_amdgcn_mfma_f32_32x32x16_bf16(__builtin_bit_cast(s16x8, wp), a, nacc, 0, 0, 0);
                }
            }
            if ((w & 1) == 0 && h32 == 0) { const int d = 32 * u_dt + r32; NPn[d] = decay * NPc[d] + nacc[0]; }
        }
        u32x2 oz[4];
        const size_t orow = rowbase + (size_t)nc * 64 + 32 * n_tt + r32;
        const size_t ocol = (size_t)h * 128 + 32 * n_et + 4 * h32;
#pragma unroll
        for (int g = 0; g < 4; ++g) oz[g] = *(const u32x2*)(F.OZ + orow * D + ocol + 8 * g);
        __syncthreads();
        f32x16 acc;
#pragma unroll
        for (int i = 0; i < 16; ++i) acc[i] = 0.f;
        const int tN = 32 * n_tt + r32;
        {
            s16x8 ia[4], ib[4], pa[4], pb[4];
#pragma unroll
            for (int ks = 0; ks < 4; ++ks) { ia[ks] = *(const LAS s16x8*)(L + O_CT + ((32 * n_et + r32) * CTS + 16 * ks + 8 * h32) * 2); ib[ks] = *(const LAS s16x8*)(L + O_QS + off_b(tN, 2 * ks + h32)); }
            __builtin_amdgcn_sched_barrier(0);
#pragma unroll
            for (int ks = 0; ks < 4; ++ks) { acc = __builtin_amdgcn_mfma_f32_32x32x16_bf16(ia[ks], ib[ks], acc, 0, 0, 0);
                ia[ks] = *(const LAS s16x8*)(L + O_CT + ((32 * n_et + r32) * CTS + 16 * (ks + 4) + 8 * h32) * 2); ib[ks] = *(const LAS s16x8*)(L + O_QS + off_b(tN, 2 * (ks + 4) + h32)); }
            __builtin_amdgcn_sched_barrier(0);
#pragma unroll
            for (int ks = 0; ks < 4; ++ks) { acc = __builtin_amdgcn_mfma_f32_32x32x16_bf16(ia[ks], ib[ks], acc, 0, 0, 0);
                pa[ks] = tr_frag(L + O_VS, lane, n_et, ks);
                pb[ks] = *(const LAS s16x8*)(L + O_PS + (tN * PST + 16 * ks + 8 * h32) * 2); }
            __builtin_amdgcn_sched_barrier(0);
            const float iw = G[128 + tN];
#pragma unroll
            for (int i = 0; i < 16; ++i) acc[i] *= iw;
            acc = __builtin_amdgcn_mfma_f32_32x32x16_bf16(pa[0], pb[0], acc, 0, 0, 0);
            acc = __builtin_amdgcn_mfma_f32_32x32x16_bf16(pa[1], pb[1], acc, 0, 0, 0);
            if (n_tt == 1) { acc = __builtin_amdgcn_mfma_f32_32x32x16_bf16(pa[2], pb[2], acc, 0, 0, 0); acc = __builtin_amdgcn_mfma_f32_32x32x16_bf16(pa[3], pb[3], acc, 0, 0, 0); }
            const LAS float* RS = (const LAS float*)(L + O_RS);
            const float den = iw * ((const LAS float*)(L + O_QN))[tN] + RS[tN * 2] + RS[tN * 2 + 1];
            const float rden = 1.0f / fmaxf(fabsf(den), G[192 + tN]);
            float s1 = 0.f, s2 = 0.f;
#pragma unroll
            for (int i = 0; i < 16; ++i) { acc[i] *= rden; s1 += acc[i]; s2 += acc[i] * acc[i]; }
            s1 += __shfl_xor(s1, 32); s2 += __shfl_xor(s2, 32);
            if (h32 == 0) *(LAS f32x2*)(L + O_LN + (tN * 4 + n_et) * 8) = (f32x2){s1, s2};
        }
        __syncthreads();
        {
            const LAS f32x2* P4 = (const LAS f32x2*)(L + O_LN + tN * 32);
            const f32x2 p0 = P4[0], p1 = P4[1], p2 = P4[2], p3 = P4[3];
            const float mean = ((p0.x + p1.x) + (p2.x + p3.x)) * (1.f / 128.f);
            const float var = fmaxf(((p0.y + p1.y) + (p2.y + p3.y)) * (1.f / 128.f) - mean * mean, 0.f);
            const float rstd = rsqrtf(var + EPS);
#pragma unroll
            for (int g = 0; g < 4; ++g) {
                const f32x4 mwv = *(const LAS f32x4*)(L + O_MW + (32 * n_et + 8 * g + 4 * h32) * 4);
                const float o0 = (acc[4 * g] - mean) * rstd * mwv[0] * blo(oz[g].x), o1 = (acc[4 * g + 1] - mean) * rstd * mwv[1] * bhi(oz[g].x);
                const float o2 = (acc[4 * g + 2] - mean) * rstd * mwv[2] * blo(oz[g].y), o3 = (acc[4 * g + 3] - mean) * rstd * mwv[3] * bhi(oz[g].y);
                u32x2 o; o.x = pkbf(o0, o1); o.y = pkbf(o2, o3);
                *(u32x2*)(F.HA + orow * D + ocol + 8 * g) = o;
            }
        }
    }
    __syncthreads();
}

namespace sg { constexpr int WST = 136, O_WB = 0, O_VN = O_WB + 128 * WST * 2, O_ST = O_VN + 128 * WST * 2, O_END = O_ST + 1024; }
__device__ __forceinline__ void sgu_mfma(Frame& F, int j, int nsg, int l) {
    using namespace ml;
    LAS unsigned char* L = F.lds;
    const int tid = F.tid, lane = F.lane, w = F.wave, r32 = lane & 31, h32 = lane >> 5;
    const int g = j & 7, idx = j >> 3, nper = nsg >> 3;
    {
        const int t = tid >> 2, s0 = (tid & 3) * 32;
        const float* Wg = F.w_s + (((size_t)l * NG + g) * SGT + t) * SGT + s0;
#pragma unroll
        for (int q = 0; q < 4; ++q) { const f32x4 a = *(const f32x4*)(Wg + 8 * q), b = *(const f32x4*)(Wg + 8 * q + 4); const int s = s0 + 8 * q;
            u32x4 o; o.x = pkbf(s <= t ? a[0] : 0.f, s + 1 <= t ? a[1] : 0.f); o.y = pkbf(s + 2 <= t ? a[2] : 0.f, s + 3 <= t ? a[3] : 0.f);
            o.z = pkbf(s + 4 <= t ? b[0] : 0.f, s + 5 <= t ? b[1] : 0.f); o.w = pkbf(s + 6 <= t ? b[2] : 0.f, s + 7 <= t ? b[3] : 0.f);
            *(LAS u32x4*)(L + sg::O_WB + (t * sg::WST + s) * 2) = o; }
    }
    const int fcg = tid & 15, fsb = tid >> 4;
    float nw[8], nb[8];
    {
        const float* pw = F.sgw + (size_t)l * D + g * 128 + 8 * fcg; const float* pb = F.sgb + (size_t)l * D + g * 128 + 8 * fcg;
        const f32x4 a = *(const f32x4*)pw, b = *(const f32x4*)(pw + 4), c = *(const f32x4*)pb, d = *(const f32x4*)(pb + 4);
        nw[0] = a[0]; nw[1] = a[1]; nw[2] = a[2]; nw[3] = a[3]; nw[4] = b[0]; nw[5] = b[1]; nw[6] = b[2]; nw[7] = b[3];
        nb[0] = c[0]; nb[1] = c[1]; nb[2] = c[2]; nb[3] = c[3]; nb[4] = d[0]; nb[5] = d[1]; nb[6] = d[2]; nb[7] = d[3];
    }
    const int ct = w & 3, ttA = w >> 2;
    for (int p = idx; p < BATCH * 16; p += nper) {
        const size_t row0 = (size_t)(p >> 4) * SEQ + (size_t)(p & 15) * SGT;
        if (tid < 128) {
            const f32x4* st = (const f32x4*)(F.VBST + (row0 + tid) * 32);
            float s1 = 0.f, s2 = 0.f;
#pragma unroll
            for (int q = 0; q < 8; ++q) { const f32x4 a = st[q]; s1 += a[0] + a[2]; s2 += a[1] + a[3]; }
            const float mean = s1 * (1.f / D), var = fmaxf(s2 * (1.f / D) - mean * mean, 0.f);
            *(LAS f32x2*)(L + sg::O_ST + tid * 8) = (f32x2){mean, rsqrtf(var + EPS)};
        }
        u32x4 rv[4];
#pragma unroll
        for (int i = 0; i < 4; ++i) rv[i] = *(const u32x4*)(F.VB + (row0 + 4 * fsb + i) * D + g * 128 + 8 * fcg);
        __syncthreads();
        {
            float mu[4], rs[4];
#pragma unroll
            for (int i = 0; i < 4; ++i) { const f32x2 st = *(const LAS f32x2*)(L + sg::O_ST + (4 * fsb + i) * 8); mu[i] = st.x; rs[i] = st.y; }
#pragma unroll
            for (int c2 = 0; c2 < 4; ++c2) {
                float ya[4], yb[4];
#pragma unroll
                for (int i = 0; i < 4; ++i) { const unsigned wd = c2 == 0 ? rv[i].x : (c2 == 1 ? rv[i].y : (c2 == 2 ? rv[i].z : rv[i].w));
                    ya[i] = (blo(wd) - mu[i]) * rs[i] * nw[2 * c2] + nb[2 * c2]; yb[i] = (bhi(wd) - mu[i]) * rs[i] * nw[2 * c2 + 1] + nb[2 * c2 + 1]; }
                u32x2 oa, ob; oa.x = pkbf(ya[0], ya[1]); oa.y = pkbf(ya[2], ya[3]); ob.x = pkbf(yb[0], yb[1]); ob.y = pkbf(yb[2], yb[3]);
                *(LAS u32x2*)(L + sg::O_VN + ((8 * fcg + 2 * c2) * sg::WST + 4 * fsb) * 2) = oa;
                *(LAS u32x2*)(L + sg::O_VN + ((8 * fcg + 2 * c2 + 1) * sg::WST + 4 * fsb) * 2) = ob;
            }
        }
        __syncthreads();
#pragma unroll
        for (int half = 0; half < 2; ++half) {
            const int tt = half == 0 ? ttA : 3 - ttA;
            const int t = 32 * tt + r32;
            const size_t orow = row0 + t; const size_t ocol = (size_t)g * 128 + 32 * ct + 4 * h32;
            u32x2 uz[4];
#pragma unroll
            for (int q = 0; q < 4; ++q) uz[q] = *(const u32x2*)(F.UZ + orow * D + ocol + 8 * q);
            const float bs = F.b_s[((size_t)l * NG + g) * SGT + t];
            f32x16 acc;
#pragma unroll
            for (int i = 0; i < 16; ++i) acc[i] = 0.f;
            const int nks = 2 * (tt + 1);
            for (int ks = 0; ks < nks; ++ks) {
                const s16x8 a = *(const LAS s16x8*)(L + sg::O_VN + ((32 * ct + r32) * sg::WST + 16 * ks + 8 * h32) * 2);
                const s16x8 b = *(const LAS s16x8*)(L + sg::O_WB + (t * sg::WST + 16 * ks + 8 * h32) * 2);
                acc = __builtin_amdgcn_mfma_f32_32x32x16_bf16(a, b, acc, 0, 0, 0);
            }
#pragma unroll
            for (int q = 0; q < 4; ++q) { u32x2 o; o.x = pkbf(blo(uz[q].x) * (acc[4 * q] + bs), bhi(uz[q].x) * (acc[4 * q + 1] + bs)); o.y = pkbf(blo(uz[q].y) * (acc[4 * q + 2] + bs), bhi(uz[q].y) * (acc[4 * q + 3] + bs));
                *(u32x2*)(F.HB + orow * D + ocol + 8 * q) = o; }
        }
        __syncthreads();
    }
}

__device__ __forceinline__ void sgu_simple(Frame& F, int u, int l) {
    LAS float* vn = (LAS float*)F.lds; LAS float* smu = vn + 128 * 64; LAS float* srs = smu + 128;
    const int ch = u & 1, g = (u >> 1) & 7, nb = (u >> 4) & 15, bb = u >> 8;
    const int lane = F.lane, wv = F.wave;
    const size_t row0 = (size_t)bb * SEQ + nb * SGT;
    for (int s = wv; s < 128; s += NWAVES) {
        const bf16* vr = F.VB + (row0 + s) * D;
        float x[16], sum = 0.f;
#pragma unroll
        for (int j = 0; j < 16; ++j) { x[j] = bf2f(vr[lane + 64 * j]); sum += x[j]; }
        const float mu = wave_sum(sum) * (1.f / D);
        float q = 0.f;
#pragma unroll
        for (int j = 0; j < 16; ++j) { const float d = x[j] - mu; q += d * d; }
        const float var = wave_sum(q) * (1.f / D);
        if (lane == 0) { smu[s] = mu; srs[s] = rsqrtf(var + EPS); }
    }
    __syncthreads();
    const int c = g * 128 + ch * 64 + lane;
    const float w_ = F.sgw[(size_t)l * D + c], b_ = F.sgb[(size_t)l * D + c];
    for (int s = wv; s < 128; s += NWAVES) vn[s * 64 + lane] = (bf2f(F.VB[(row0 + s) * D + c]) - smu[s]) * srs[s] * w_ + b_;
    __syncthreads();
    const float* W = F.w_s + ((size_t)l * NG + g) * SGT * SGT;
    const float* bs = F.b_s + ((size_t)l * NG + g) * SGT;
    for (int t = wv; t < 128; t += NWAVES) {
        float acc = 0.f;
        for (int s = 0; s <= t; ++s) acc += W[t * SGT + s] * vn[s * 64 + lane];
        acc += bs[t];
        F.HB[(row0 + t) * D + c] = f2bf(bf2f(F.UZ[(row0 + t) * D + c]) * acc);
    }
    __syncthreads();
}
__device__ __forceinline__ void p5_rows(Frame& F, int l) {
    const int gw = blockIdx.x * NWAVES + F.wave, NGW = F.G * NWAVES, lane = F.lane;
    const float* xin; if (l == 0) xin = F.x; else xin = F.out;
    const GAS f32x4* wpost = (const GAS f32x4*)(F.norm_post + (size_t)l * D) + lane;
    const GAS f32x4* wpre = (const GAS f32x4*)(F.norm_pre + (size_t)(l + 1 < DEPTH ? l + 1 : l) * D) + lane;
    for (int m = gw; m < M; m += NGW) {
        const GAS f32x4* orow = (const GAS f32x4*)(F.OUTRAW + (size_t)m * D) + lane; const GAS f32x4* xr = (const GAS f32x4*)(xin + (size_t)m * D) + lane;
        GAS f32x4* xo = (GAS f32x4*)(F.out + (size_t)m * D) + lane;
        f32x4 v[4], xv[4]; float s = 0.f;
#pragma unroll
        for (int j = 0; j < 4; ++j) { v[j] = orow[64 * j]; xv[j] = xr[64 * j]; s += (v[j].x * v[j].x + v[j].y * v[j].y) + (v[j].z * v[j].z + v[j].w * v[j].w); }
        const float rstd = rsqrtf(wave_sum(s) * (1.f / D) + EPS); float s2 = 0.f;
#pragma unroll
        for (int j = 0; j < 4; ++j) { xv[j] = xv[j] + v[j] * rstd * wpost[64 * j]; xo[64 * j] = xv[j]; s2 += (xv[j].x * xv[j].x + xv[j].y * xv[j].y) + (xv[j].z * xv[j].z + xv[j].w * xv[j].w); }
        if (l + 1 < DEPTH) {
            const float r2 = rsqrtf(wave_sum(s2) * (1.f / D) + EPS);
            GAS unsigned long long* o8 = (GAS unsigned long long*)(F.XN + (size_t)m * D) + lane;
#pragma unroll
            for (int j = 0; j < 4; ++j) { const f32x4 ww = wpre[64 * j];
                o8[64 * j] = (unsigned long long)pk2(xv[j].x * r2 * ww.x, xv[j].y * r2 * ww.y) | ((unsigned long long)pk2(xv[j].z * r2 * ww.z, xv[j].w * r2 * ww.w) << 32); }
        }
    }
}


#ifndef PG8_SP2
#define PG8_SP2 true
#endif
#ifndef PG8_ALIGN
#define PG8_ALIGN true
#endif
#ifndef SGU_SIMPLE
#define SGU_SIMPLE 0
#endif
#ifndef REPEAT_MASK
#define REPEAT_MASK 0
#endif
#ifndef MLSTM_SIMPLE
#define MLSTM_SIMPLE 0
#endif
#ifndef NAIVE_MASK
#define NAIVE_MASK 0
#endif
__device__ __forceinline__ void naive_tile(Frame& F, const bf16* A, const bf16* Bt, int row0, int col0, float (&acc)[2][16]) {
    LAS float* sA = (LAS float*)F.lds; LAS float* sB = sA + 64 * 33;
    const int tid = F.tid, tx = tid & 15, ty = tid >> 4;
#pragma unroll
    for (int i = 0; i < 2; ++i)
#pragma unroll
        for (int j = 0; j < 16; ++j) acc[i][j] = 0.f;
    for (int k0 = 0; k0 < D; k0 += 32) {
        for (int i = tid; i < 64 * 32; i += 512) { const int r = i >> 5, c = i & 31; sA[r * 33 + c] = bf2f(A[(size_t)(row0 + r) * D + k0 + c]); }
        for (int i = tid; i < 256 * 32; i += 512) { const int r = i >> 5, c = i & 31; sB[r * 33 + c] = bf2f(Bt[(size_t)(col0 + r) * D + k0 + c]); }
        __syncthreads();
#pragma unroll 4
        for (int kk = 0; kk < 32; ++kk) {
            float a[2], b[16];
#pragma unroll
            for (int i = 0; i < 2; ++i) a[i] = sA[(ty * 2 + i) * 33 + kk];
#pragma unroll
            for (int j = 0; j < 16; ++j) b[j] = sB[(tx + 16 * j) * 33 + kk];
#pragma unroll
            for (int i = 0; i < 2; ++i)
#pragma unroll
                for (int j = 0; j < 16; ++j) acc[i][j] += a[i] * b[j];
        }
        __syncthreads();
    }
}
__device__ __forceinline__ void naive_p1(Frame& F, int l) {
    const bf16* WT = F.WIN + (size_t)l * NP1 * D; const float* B1 = F.B1 + (size_t)l * NP1;
    const int tx = F.tid & 15, ty = F.tid >> 4;
    for (int it = blockIdx.x; it < (M / 64) * NT1; it += F.G) {
        const int t = it % NT1, row0 = (it / NT1) * 64, col0 = t * 256;
        float acc[2][16];
        naive_tile(F, F.XN, WT, row0, col0, acc);
#pragma unroll
        for (int i = 0; i < 2; ++i) { const size_t row = row0 + ty * 2 + i;
#pragma unroll
            for (int jj = 0; jj < 16; ++jj) { const int j = tx + 16 * jj; const float v = acc[i][jj] + B1[col0 + j];
                if (t < 8) F.QK[row * 2048 + col0 + j] = f2bf(v);
                else if (t < 12) F.V[row * D + (col0 - 2048) + j] = f2bf(v);
                else if (t < 28) { if (jj < 8) { const float v2 = acc[i][jj + 8] + B1[col0 + j + 128];
                        if (t < 20) F.OZ[row * D + 128 * (t - 12) + j] = f2bf(sigmoidf_(v) * siluf_(v2)); else F.UZ[row * D + 128 * (t - 20) + j] = f2bf(geluf_(v) * siluf_(v2)); } }
                else if (t < 32) F.VB[row * D + 256 * (t - 28) + j] = f2bf(geluf_(v));
                else if (t < 36) F.GA[row * D + 256 * (t - 32) + j] = f2bf(sigmoidf_(v));
                else if (t < 40) F.GB[row * D + 256 * (t - 36) + j] = f2bf(sigmoidf_(v));
                else { if (j < 16) F.IF[row * 16 + j] = v; } } }
    }
}
__device__ __forceinline__ void naive_p3(Frame& F, int l) {
    const bf16* WA = F.WAB + (size_t)l * 2048 * D; const bf16* WB = WA + (size_t)1024 * D;
    const int tx = F.tid & 15, ty = F.tid >> 4;
    for (int it = blockIdx.x; it < (M / 64) * 4; it += F.G) {
        const int row0 = (it >> 2) * 64, col0 = (it & 3) * 256;
        float acc[2][16], tmp[2][16];
        naive_tile(F, F.HA, WA, row0, col0, acc);
#pragma unroll
        for (int i = 0; i < 2; ++i)
#pragma unroll
            for (int jj = 0; jj < 16; ++jj) tmp[i][jj] = acc[i][jj] * bf2f(F.GA[(size_t)(row0 + ty * 2 + i) * D + col0 + tx + 16 * jj]);
        naive_tile(F, F.HB, WB, row0, col0, acc);
#pragma unroll
        for (int i = 0; i < 2; ++i)
#pragma unroll
            for (int jj = 0; jj < 16; ++jj) { const size_t o = (size_t)(row0 + ty * 2 + i) * D + col0 + tx + 16 * jj; F.MG[o] = f2bf(tmp[i][jj] + acc[i][jj] * bf2f(F.GB[o])); }
    }
}
__device__ __forceinline__ void naive_p4(Frame& F, int l) {
    const bf16* WO = F.WO + (size_t)l * D * D;
    const int tx = F.tid & 15, ty = F.tid >> 4;
    for (int it = blockIdx.x; it < (M / 64) * 4; it += F.G) {
        const int row0 = (it >> 2) * 64, col0 = (it & 3) * 256;
        float acc[2][16];
        naive_tile(F, F.MG, WO, row0, col0, acc);
#pragma unroll
        for (int i = 0; i < 2; ++i)
#pragma unroll
            for (int jj = 0; jj < 16; ++jj) F.OUTRAW[(size_t)(row0 + ty * 2 + i) * D + col0 + tx + 16 * jj] = acc[i][jj];
    }
}

struct Args { const float* in[15]; float* out; unsigned char* ws; int ph_lo, ph_hi, li, pad; };
constexpr int NPHASES = 1 + 5 * DEPTH;
#ifndef PHSEL
#define PHSEL 63
#endif
__global__ void __launch_bounds__(NWAVES * 64, 2) mk_fwd(Args args) {
    extern __shared__ __attribute__((aligned(16))) unsigned char lds[];
    Frame F;
    F.lds = (LAS unsigned char*)lds;
    F.MISC = (volatile LAS unsigned*)(F.lds + MISC_OFF);
    F.tid = threadIdx.x; F.lane = F.tid & 63; F.wave = __builtin_amdgcn_readfirstlane(F.tid >> 6); F.G = gridDim.x;
    unsigned char* ws = args.ws;
    F.ctl = (gu32*)(ws + WS_CTL);
    F.x = args.in[0]; F.norm_pre = args.in[1]; F.norm_post = args.in[2]; F.w_in = args.in[3]; F.b_in = args.in[4]; F.conv_w = args.in[5]; F.conv_b = args.in[6];
    F.mhw = args.in[7]; F.sgw = args.in[8]; F.sgb = args.in[9]; F.w_s = args.in[10]; F.b_s = args.in[11]; F.w_a = args.in[12]; F.w_b = args.in[13]; F.w_out = args.in[14];
    F.out = args.out;
    F.WIN = (bf16*)(ws + WS_WIN); F.WAB = (bf16*)(ws + WS_WAB); F.WO = (bf16*)(ws + WS_WO); F.B1 = (float*)(ws + WS_B1);
    F.XN = (bf16*)(ws + WS_XN); F.QK = (bf16*)(ws + WS_QK); F.V = (bf16*)(ws + WS_V); F.OZ = (bf16*)(ws + WS_OZ); F.UZ = (bf16*)(ws + WS_UZ); F.VB = (bf16*)(ws + WS_VB);
    F.GA = (bf16*)(ws + WS_GA); F.GB = (bf16*)(ws + WS_GB); F.HA = (bf16*)(ws + WS_HA); F.HB = (bf16*)(ws + WS_HB); F.MG = (bf16*)(ws + WS_MG);
    F.IF = (float*)(ws + WS_IF); F.MGF = (float*)(ws + WS_MGF); F.OUTRAW = (float*)(ws + WS_OUTRAW); F.VBST = (float*)(ws + WS_VBST);
    for (int u = F.tid; u < (LDS_BYTES - LDSCTL_OFF) / 4; u += NWAVES * 64) ((LAS unsigned*)(F.lds + LDSCTL_OFF))[u] = 0u;
    __syncthreads();
    const int lo = args.ph_lo, hi = args.ph_hi;
    XcdBarrier bar; bar.bar = (unsigned*)(F.ctl + CW_BAR); bar.x = 0; bar.st = nullptr;
    if (hi - lo > 1) bar = xcd_barrier_post((unsigned*)(F.ctl + CW_BAR), F.MISC + 8);

    for (int ph = lo; ph < hi; ++ph) {
        for (int rep_ = 0; rep_ < 2; ++rep_) {
        if (rep_ == 1) { const int sub_ = ph == 0 ? -1 : (ph - 1) % 5; const int bit_ = ph == 0 ? 1 : (sub_ == 0 ? 2 : (sub_ == 1 ? (blockIdx.x < 64 ? 4 : 8) : (sub_ == 2 ? 16 : (sub_ == 3 ? 32 : 0)))); if (!(REPEAT_MASK & bit_)) break; }
        { int t_ = threadIdx.x; asm volatile("" : "+v"(t_)); F.tid = t_; F.lane = t_ & 63; }
        if (ph == 0) { if (PHSEL & 1) p0_prologue(F); }
        else {
            const int l = (ph - 1) / 5, sub = (ph - 1) % 5;
            if (sub == 0 && (NAIVE_MASK & 1)) naive_p1(F, l);
            else if (sub == 2 && (NAIVE_MASK & 2)) naive_p3(F, l);
            else if (sub == 3 && (NAIVE_MASK & 4)) naive_p4(F, l);
            else if (sub == 0 && (PHSEL & 2)) {
                pg8::Gemm g{F.XN, F.WIN + (size_t)l * NP1 * D, M, NP1, D}; pg8::StaticOrder S; S.init(M, NP1, F.G, (int)blockIdx.x);
                pg8::EpiP1 E{F.B1 + (size_t)l * NP1, F.QK, F.V, F.OZ, F.UZ, F.VB, F.GA, F.GB, F.IF, F.VBST};
                pg8::gemm_phase<pg8::EpiP1, pg8::StaticOrder, PG8_ALIGN, PG8_SP2>(F.lds + RING_OFF, g, S, E);
            } else if (sub == 1 && (PHSEL & 4)) {
                if (blockIdx.x < 64) { if (MLSTM_SIMPLE) mlstm_simple(F, blockIdx.x, l); else mlstm_mfma(F, blockIdx.x, l); }
                else if (SGU_SIMPLE) { for (int u = blockIdx.x - 64; u < BATCH * 16 * NG * 2; u += F.G - 64) sgu_simple(F, u, l); }
                else { sgu_mfma(F, blockIdx.x - 64, F.G - 64, l);
                    if (l + 1 < DEPTH && rep_ == 0) { __syncthreads(); convert_layer_weights(F, l + 1, (blockIdx.x - 64) * NWAVES + F.wave, (F.G - 64) * NWAVES, (blockIdx.x - 64) * 512 + F.tid, (F.G - 64) * 512); } }
            } else if (sub == 2 && (PHSEL & 8)) {
                if (F.G == 256) {
                    pg8::Gemm g{F.HA, F.WAB + (size_t)l * 2048 * D, M, 2048, D}; pg8::PairOrder S{(int)blockIdx.x, (size_t)(WS_HB - WS_HA)};
                    pg8::EpiMerge E{F.GA, F.GB, F.MGF, F.MG};
                    pg8::gemm_phase<pg8::EpiMerge, pg8::PairOrder, PG8_ALIGN, PG8_SP2>(F.lds + RING_OFF, g, S, E);
                }
            } else if (sub == 3 && (PHSEL & 16)) {
                pg8::Gemm g{F.MG, F.WO + (size_t)l * D * D, M, D, D}; pg8::StaticOrder S; S.init(M, D, F.G, (int)blockIdx.x);
                pg8::EpiF32 E{F.OUTRAW, D};
                pg8::gemm_phase<pg8::EpiF32, pg8::StaticOrder, PG8_ALIGN, PG8_SP2>(F.lds + RING_OFF, g, S, E);
            } else if (sub == 4 && (PHSEL & 32)) p5_rows(F, l);
        }
        }
        if (ph + 1 < hi) xcd_barrier(bar);
    }
}

extern "C" void kernel_launch(void* const* d_in, const int* in_sizes, int n_in, void* d_out, int out_size, void* d_ws, size_t ws_size, hipStream_t stream) {
    static int grid = 0;
    if (grid == 0) {
        if (n_in != 15 || in_sizes[0] != M * D || out_size != M * D || ws_size < WS_END) { fprintf(stderr, "kernel_launch: unexpected shapes: n_in %d out %d ws %zu; nothing launched\n", n_in, out_size, ws_size); grid = -1; return; }
        int dev = 0, cus = 0;
        if (hipGetDevice(&dev) != hipSuccess || hipDeviceGetAttribute(&cus, hipDeviceAttributeMultiprocessorCount, dev) != hipSuccess) { grid = -1; return; }
        if (hipFuncSetAttribute((const void*)mk_fwd, hipFuncAttributeMaxDynamicSharedMemorySize, LDS_BYTES) != hipSuccess) { fprintf(stderr, "kernel_launch: hipFuncSetAttribute failed\n"); grid = -1; return; }
        int per_cu = 0;
        if (hipOccupancyMaxActiveBlocksPerMultiprocessor(&per_cu, (const void*)mk_fwd, NWAVES * 64, LDS_BYTES) != hipSuccess || per_cu < 1) fprintf(stderr, "kernel_launch: occupancy query says %d blocks per CU\n", per_cu);
        (void)hipGetLastError();
        grid = cus;
        if (grid != 256) fprintf(stderr, "kernel_launch: %d CUs; this kernel is built for 256\n", grid);
    }
    if (grid < 0) return;
    if (hipMemsetAsync((char*)d_ws + WS_CTL, 0, CTL_ZERO_BYTES, stream) != hipSuccess) return;
    Args a{};
    for (int i = 0; i < 15; ++i) a.in[i] = (const float*)d_in[i];
    a.out = (float*)d_out; a.ws = (unsigned char*)d_ws;
#if MK_ONE_LAUNCH
    a.ph_lo = 0; a.ph_hi = NPHASES; a.li = 0;
    hipLaunchKernelGGL(mk_fwd, dim3(grid), dim3(NWAVES * 64), LDS_BYTES, stream, a);
#else
    for (int ph = 0; ph < NPHASES; ++ph) { a.ph_lo = ph; a.ph_hi = ph + 1; a.li = ph; hipLaunchKernelGGL(mk_fwd, dim3(grid), dim3(NWAVES * 64), LDS_BYTES, stream, a); }
#endif
}
```
